# Optimizing an MI355X kernel written in HIP

```python
import math
import jax, jax.numpy as jnp
from jax import lax
import numpy as np

D_MODEL = 1024
BATCH = 4
SEQ = 8192
DEPTH = 1

POOL_WIDTH = D_MODEL // 2
POOL_WINDOWS = (2, 4, 8, 16)
POOL_GROUPS = len(POOL_WINDOWS)
POOL_GC = POOL_WIDTH // POOL_GROUPS
HEAD_DIM = 64
ATTN_HEADS = (D_MODEL // 2) // HEAD_DIM
ATTN_WIDTH = ATTN_HEADS * HEAD_DIM
MOBA_BLOCK = 256
MOBA_TOPK = 3
QUERY_CHUNK = 64
ROPE_THETA = 500000.0
ROT_DIM = HEAD_DIM // 4
N_BRANCH = 2
IN_WIDTH = 2 * POOL_WIDTH + 4 * ATTN_WIDTH + N_BRANCH * D_MODEL
EPS = 1e-6

kernel_name = "hybrid_pool_moba_gated_adaln"


def rms_norm(x, g):
    xf = x.astype(jnp.float32)
    y = xf * lax.rsqrt(jnp.mean(xf * xf, axis=-1, keepdims=True) + EPS)
    return (y * g.astype(jnp.float32)).astype(x.dtype)


def partial_rope(x):
    S_ = x.shape[1]
    half = ROT_DIM // 2
    pos = jnp.arange(S_, dtype=jnp.float32)
    inv_freq = ROPE_THETA ** (-jnp.arange(0, ROT_DIM, 2, dtype=jnp.float32) / ROT_DIM)
    ang = pos[:, None] * inv_freq[None, :]
    cos = jnp.cos(ang)[None, :, None, :].astype(x.dtype)
    sin = jnp.sin(ang)[None, :, None, :].astype(x.dtype)
    x1 = x[..., :half]
    x2 = x[..., half:ROT_DIM]
    return jnp.concatenate([x1 * cos - x2 * sin, x2 * cos + x1 * sin, x[..., ROT_DIM:]], axis=-1)


def multiscale_pool(u, w_grp, scale):
    B_, S_, _ = u.shape
    ug = u.reshape(B_, S_, POOL_GROUPS, POOL_GC)
    uf = ug.astype(jnp.float32)
    cs = lax.cumsum(uf, axis=1)
    cs = jnp.concatenate([jnp.zeros_like(cs[:, :1]), cs], axis=1)
    t = jnp.arange(S_)
    means = []
    for g, w in enumerate(POOL_WINDOWS):
        hi = t + 1
        lo = jnp.maximum(t + 1 - w, 0)
        cnt = (hi - lo).astype(jnp.float32)[None, :, None]
        means.append((cs[:, hi, g] - cs[:, lo, g]) / cnt)
    d = (jnp.stack(means, axis=2) - uf).astype(u.dtype)
    y = jnp.einsum('bsgc,gcd->bsgd', d, w_grp).reshape(B_, S_, POOL_WIDTH)
    return y * scale


def moba_attention(q, k, v):
    B_, S_, H, Dh = q.shape
    q = q.transpose(0, 2, 1, 3)
    k = k.transpose(0, 2, 1, 3)
    v = v.transpose(0, 2, 1, 3)
    nb = -(-S_ // MOBA_BLOCK)
    s_pad = nb * MOBA_BLOCK
    pad = ((0, 0), (0, 0), (0, s_pad - S_), (0, 0))
    kb = jnp.pad(k, pad).reshape(B_, H, nb, MOBA_BLOCK, Dh)
    vb = jnp.pad(v, pad).reshape(B_, H, nb, MOBA_BLOCK, Dh)
    kmean = jnp.mean(kb.astype(jnp.float32), axis=3)
    n_sel = min(MOBA_TOPK, nb)
    nq = S_ // QUERY_CHUNK
    q_chunks = q.reshape(B_, H, nq, QUERY_CHUNK, Dh).transpose(2, 0, 1, 3, 4)
    scale = Dh ** -0.5
    bi = jnp.arange(B_)[:, None, None, None]
    hi = jnp.arange(H)[None, :, None, None]
    blk_ids = jnp.arange(nb)
    kr = jnp.arange(MOBA_BLOCK)

    def one_chunk(args):
        ci, qc = args
        q0 = ci * QUERY_CHUNK
        qblk = q0 // MOBA_BLOCK
        qpos = q0 + jnp.arange(QUERY_CHUNK)
        gate = jnp.einsum('bhqd,bhnd->bhqn', qc.astype(jnp.float32), kmean)
        gate = jnp.where(blk_ids < qblk, gate, -jnp.inf)
        _, sel = lax.top_k(gate, n_sel)
        sel_ok = sel < qblk
        ksel = kb[bi, hi, sel]
        vsel = vb[bi, hi, sel]
        s_sel = jnp.einsum('bhqd,bhqkjd->bhqkj', qc, ksel).astype(jnp.float32) * scale
        s_sel = jnp.where(sel_ok[..., None], s_sel, -jnp.inf)
        s_sel = s_sel.reshape(B_, H, QUERY_CHUNK, n_sel * MOBA_BLOCK)
        kown = lax.dynamic_index_in_dim(kb, qblk, axis=2, keepdims=False)
        vown = lax.dynamic_index_in_dim(vb, qblk, axis=2, keepdims=False)
        kpos = qblk * MOBA_BLOCK + kr
        s_own = jnp.einsum('bhqd,bhjd->bhqj', qc, kown).astype(jnp.float32) * scale
        s_own = jnp.where(kpos[None, :] <= qpos[:, None], s_own, -jnp.inf)
        p = jax.nn.softmax(jnp.concatenate([s_sel, s_own], axis=-1), axis=-1).astype(v.dtype)
        p_sel = p[..., :n_sel * MOBA_BLOCK].reshape(B_, H, QUERY_CHUNK, n_sel, MOBA_BLOCK)
        p_own = p[..., n_sel * MOBA_BLOCK:]
        return (jnp.einsum('bhqkj,bhqkjd->bhqd', p_sel, vsel)
                + jnp.einsum('bhqj,bhjd->bhqd', p_own, vown))

    out = lax.map(one_chunk, (jnp.arange(nq), q_chunks))
    return out.transpose(1, 0, 3, 2, 4).reshape(B_, S_, H * Dh)


def setup_inputs(seed: int = 0) -> dict:
    key = jax.random.key(seed)
    ks = jax.random.split(key, 14)
    D = D_MODEL
    nrm = jax.random.normal
    return {
        "x": nrm(ks[0], (BATCH, SEQ, D), jnp.float32),
        "c": nrm(ks[1], (BATCH, D), jnp.float32),
        "w_ada": nrm(ks[2], (DEPTH, D, 3 * D), jnp.float32) * (0.3 * D ** -0.5),
        "b_ada": nrm(ks[3], (DEPTH, 3 * D), jnp.float32) * 0.01,
        "g_norm": 1.0 + 0.05 * nrm(ks[4], (DEPTH, D), jnp.float32),
        "w_in": nrm(ks[5], (DEPTH, D, IN_WIDTH), jnp.float32) * D ** -0.5,
        "w_pool_grp": nrm(ks[6], (DEPTH, POOL_GROUPS, POOL_GC, POOL_GC), jnp.float32) * POOL_GC ** -0.5,
        "pool_scale": 1.0 + 0.1 * nrm(ks[7], (DEPTH, POOL_WIDTH), jnp.float32),
        "w_pool_up": nrm(ks[8], (DEPTH, POOL_WIDTH, D), jnp.float32) * POOL_WIDTH ** -0.5,
        "w_attn_up": nrm(ks[9], (DEPTH, ATTN_WIDTH, D), jnp.float32) * ATTN_WIDTH ** -0.5,
        "w_out": nrm(ks[10], (DEPTH, D, D), jnp.float32) * D ** -0.5,
        "g_final": 1.0 + 0.05 * nrm(ks[11], (D,), jnp.float32),
    }


def reference(x, c, w_ada, b_ada, g_norm, w_in, w_pool_grp, pool_scale, w_pool_up, w_attn_up, w_out, g_final):
    B_, S_, D = x.shape
    splits = np.cumsum([POOL_WIDTH, POOL_WIDTH, ATTN_WIDTH, ATTN_WIDTH, ATTN_WIDTH, ATTN_WIDTH, D_MODEL]).tolist()
    for l in range(DEPTH):
        mod = c @ w_ada[l] + b_ada[l]
        shift, scl, gate = jnp.split(mod, 3, axis=-1)
        h = rms_norm(x, g_norm[l]) * (1.0 + scl[:, None, :]) + shift[:, None, :]
        proj = h @ w_in[l]
        u_pool, z_pool, q, k, v, z_attn, m_pool, m_attn = jnp.split(proj, splits, axis=-1)
        y_pool = multiscale_pool(u_pool, w_pool_grp[l], pool_scale[l]) * jax.nn.silu(z_pool)
        y_pool = y_pool @ w_pool_up[l]
        q = partial_rope(q.reshape(B_, S_, ATTN_HEADS, HEAD_DIM))
        k = partial_rope(k.reshape(B_, S_, ATTN_HEADS, HEAD_DIM))
        v = v.reshape(B_, S_, ATTN_HEADS, HEAD_DIM)
        y_attn = moba_attention(q, k, v) * jax.nn.silu(z_attn)
        y_attn = y_attn @ w_attn_up[l]
        merged = jax.nn.sigmoid(m_pool) * y_pool + jax.nn.sigmoid(m_attn) * y_attn
        x = x + gate[:, None, :] * (merged @ w_out[l])
    return rms_norm(x, g_final)
```

```cpp
#include <hip/hip_runtime.h>
#include <cstdint>
#include <cstdio>

typedef unsigned short bf16;
typedef float f32x4 __attribute__((ext_vector_type(4)));
typedef unsigned u32x4 __attribute__((ext_vector_type(4)));

constexpr int DM = 1024, BATCH = 4, SEQ = 8192, M = BATCH * SEQ;
constexpr int PW = 512, NG = 4, GC = 128, NH = 8, HD = 64, AW = 512, BLK = 256, NB = SEQ / BLK, TOPK = 3;
constexpr int INW = 5120;
constexpr float EPS = 1e-6f;
constexpr float C2 = 0.125f * 1.4426950408889634f;

constexpr size_t MiB = 1u << 20;
constexpr size_t WS_MOD = 1 * MiB, WS_KMEAN = 1 * MiB + 256 * 1024, WS_ROPE = 2 * MiB;
constexpr size_t WS_H = 32 * MiB, WS_D = 32 * MiB, WS_YP = 64 * MiB;
constexpr size_t WS_U = 96 * MiB, WS_SZP = 128 * MiB, WS_Q = 160 * MiB, WS_YA = 160 * MiB, WS_K = 192 * MiB, WS_V = 224 * MiB, WS_MG = 192 * MiB;
constexpr size_t WS_SZA = 256 * MiB, WS_SP = 288 * MiB, WS_SA = 352 * MiB;

__device__ __forceinline__ float bf2f(bf16 v) { return __uint_as_float((unsigned)v << 16); }
__device__ __forceinline__ bf16 f2bf(float f) { unsigned u = __float_as_uint(f); return (bf16)((u + 0x7fffu + ((u >> 16) & 1u)) >> 16); }
__device__ __forceinline__ float siluf(float z) { return z / (1.f + __expf(-z)); }
__device__ __forceinline__ float sigmf(float z) { return 1.f / (1.f + __expf(-z)); }

__global__ void k_mod(const float* c, const float* w_ada, const float* b_ada, float* mod) {
    int n = blockIdx.x * blockDim.x + threadIdx.x; if (n >= 3 * DM) return;
    float a0 = b_ada[n], a1 = a0, a2 = a0, a3 = a0;
    for (int k = 0; k < DM; ++k) { float w = w_ada[(size_t)k * 3 * DM + n]; a0 += c[k] * w; a1 += c[DM + k] * w; a2 += c[2 * DM + k] * w; a3 += c[3 * DM + k] * w; }
    mod[n] = a0; mod[3 * DM + n] = a1; mod[6 * DM + n] = a2; mod[9 * DM + n] = a3;
}
__global__ void k_rope_tab(float* tab) {
    int idx = blockIdx.x * blockDim.x + threadIdx.x; if (idx >= SEQ * 8) return;
    int pos = idx >> 3, i = idx & 7;
    double inv = exp2(-(double)i / 8.0 * log2(500000.0));
    double ang = (double)pos * inv;
    double k = rint(ang * 0.15915494309189535);
    double r = fma(-k, 6.283185307179586, ang); r = fma(-k, 2.4492935982947064e-16, r);
    float rf = (float)r;
    tab[idx * 2] = cosf(rf); tab[idx * 2 + 1] = sinf(rf);
}
__global__ void k_h(const float* x, const float* g, const float* mod, bf16* h) {
    int row = blockIdx.x * 4 + (threadIdx.x >> 6), lane = threadIdx.x & 63, b = row / SEQ;
    const f32x4* xr = (const f32x4*)(x + (size_t)row * DM) + lane;
    f32x4 v[4]; float s = 0.f;
#pragma unroll
    for (int j = 0; j < 4; ++j) { v[j] = xr[64 * j]; s += v[j].x * v[j].x + v[j].y * v[j].y + v[j].z * v[j].z + v[j].w * v[j].w; }
#pragma unroll
    for (int o = 1; o < 64; o <<= 1) s += __shfl_xor(s, o);
    float rstd = rsqrtf(s * (1.f / DM) + EPS);
    const float* shift = mod + (size_t)b * 3 * DM, * scl = shift + DM;
#pragma unroll
    for (int j = 0; j < 4; ++j) {
        int c0 = 4 * lane + 256 * j; float o[4];
#pragma unroll
        for (int e = 0; e < 4; ++e) o[e] = v[j][e] * rstd * g[c0 + e] * (1.f + scl[c0 + e]) + shift[c0 + e];
        unsigned long long pk = (unsigned long long)f2bf(o[0]) | ((unsigned long long)f2bf(o[1]) << 16) | ((unsigned long long)f2bf(o[2]) << 32) | ((unsigned long long)f2bf(o[3]) << 48);
        *(unsigned long long*)(h + (size_t)row * DM + c0) = pk;
    }
}
template <class Epi> __global__ void __launch_bounds__(256) k_gemm(const bf16* A, int lda, const float* W, int ldw, int K, Epi epi) {
    __shared__ float As[16][132]; __shared__ float Bs[16][132];
    const int tid = threadIdx.x, tx = tid & 15, ty = tid >> 4, bm = blockIdx.y * 128, bn = blockIdx.x * 128;
    float acc[8][8];
#pragma unroll
    for (int i = 0; i < 8; ++i)
#pragma unroll
        for (int j = 0; j < 8; ++j) acc[i][j] = 0.f;
    for (int k0 = 0; k0 < K; k0 += 16) {
        { int r = tid >> 1, kh = (tid & 1) * 8; u32x4 raw = *(const u32x4*)(A + (size_t)(bm + r) * lda + k0 + kh);
#pragma unroll
          for (int e = 0; e < 4; ++e) { As[kh + 2 * e][r] = __uint_as_float(raw[e] << 16); As[kh + 2 * e + 1][r] = __uint_as_float(raw[e] & 0xffff0000u); } }
        { int kk = tid >> 4, c = (tid & 15) * 8; const float* wp = W + (size_t)(k0 + kk) * ldw + bn + c; f32x4 w0 = *(const f32x4*)wp, w1 = *(const f32x4*)(wp + 4);
          *(f32x4*)&Bs[kk][c] = w0; *(f32x4*)&Bs[kk][c + 4] = w1; }
        __syncthreads();
#pragma unroll
        for (int kk = 0; kk < 16; ++kk) {
            float a[8], b[8];
#pragma unroll
            for (int i = 0; i < 8; ++i) a[i] = As[kk][ty * 8 + i];
#pragma unroll
            for (int j = 0; j < 8; ++j) b[j] = Bs[kk][tx * 8 + j];
#pragma unroll
            for (int i = 0; i < 8; ++i)
#pragma unroll
                for (int j = 0; j < 8; ++j) acc[i][j] += a[i] * b[j];
        }
        __syncthreads();
    }
#pragma unroll
    for (int i = 0; i < 8; ++i)
#pragma unroll
        for (int j = 0; j < 8; ++j) epi(bm + ty * 8 + i, bn + tx * 8 + j, acc[i][j]);
}
struct EpiIn {
    bf16 *u, *szp, *q, *k, *v, *sza, *sp, *sa;
    __device__ void operator()(int m, int n, float v_) const {
        if (n < 512) u[(size_t)m * 512 + n] = f2bf(v_);
        else if (n < 1024) szp[(size_t)m * 512 + n - 512] = f2bf(siluf(v_));
        else if (n < 1536) q[(size_t)m * 512 + n - 1024] = f2bf(v_);
        else if (n < 2048) k[(size_t)m * 512 + n - 1536] = f2bf(v_);
        else if (n < 2560) v[(size_t)m * 512 + n - 2048] = f2bf(v_);
        else if (n < 3072) sza[(size_t)m * 512 + n - 2560] = f2bf(siluf(v_));
        else if (n < 4096) sp[(size_t)m * 1024 + n - 3072] = f2bf(sigmf(v_));
        else sa[(size_t)m * 1024 + n - 4096] = f2bf(sigmf(v_));
    }
};
struct EpiGrp { bf16* yp; const bf16* szp; const float* scale; int g;
    __device__ void operator()(int m, int n, float v_) const { int c = g * 128 + n; yp[(size_t)m * 512 + c] = f2bf(v_ * scale[c] * bf2f(szp[(size_t)m * 512 + c])); } };
struct EpiPU { bf16* mg; const bf16* sp;
    __device__ void operator()(int m, int n, float v_) const { size_t i = (size_t)m * 1024 + n; mg[i] = f2bf(v_ * bf2f(sp[i])); } };
struct EpiAU { bf16* mg; const bf16* sa;
    __device__ void operator()(int m, int n, float v_) const { size_t i = (size_t)m * 1024 + n; mg[i] = f2bf(bf2f(mg[i]) + v_ * bf2f(sa[i])); } };
struct EpiOut { float* out; const float* x; const float* mod;
    __device__ void operator()(int m, int n, float v_) const { size_t i = (size_t)m * 1024 + n; int b = m / SEQ; out[i] = x[i] + mod[(size_t)b * 3 * DM + 2 * DM + n] * v_; } };

__global__ void k_rope(bf16* q, bf16* k, const float* tab) {
    int idx = blockIdx.x * blockDim.x + threadIdx.x; if (idx >= M * NH * 8) return;
    int i = idx & 7, h = (idx >> 3) & 7, m = idx >> 6, pos = m % SEQ;
    float c = tab[(pos * 8 + i) * 2], s = tab[(pos * 8 + i) * 2 + 1];
    size_t o = (size_t)m * 512 + h * 64 + i;
    float a = bf2f(q[o]), b = bf2f(q[o + 8]); q[o] = f2bf((a * c - b * s) * C2); q[o + 8] = f2bf((b * c + a * s) * C2);
    a = bf2f(k[o]); b = bf2f(k[o + 8]); k[o] = f2bf(a * c - b * s); k[o + 8] = f2bf(b * c + a * s);
}
__global__ void k_qscale(bf16* q) {
    int idx = blockIdx.x * blockDim.x + threadIdx.x; if (idx >= M * NH * 48) return;
    int d = 16 + idx % 48, mh = idx / 48; size_t o = (size_t)(mh >> 3) * 512 + (mh & 7) * 64 + d; q[o] = f2bf(bf2f(q[o]) * C2);
}
__global__ void k_kmean(const bf16* k, float* kmean) {
    int idx = blockIdx.x * blockDim.x + threadIdx.x; if (idx >= BATCH * NH * NB * 64) return;
    int d = idx & 63, j = (idx >> 6) & 31, h = (idx >> 11) & 7, b = idx >> 14;
    float s = 0.f; for (int t = 0; t < BLK; ++t) s += bf2f(k[(size_t)(b * SEQ + j * BLK + t) * 512 + h * 64 + d]);
    kmean[idx] = s * (1.f / BLK);
}
__global__ void __launch_bounds__(64) k_attn(const bf16* Q, const bf16* Kb, const bf16* Vb, const float* kmean, const bf16* sza, bf16* ya) {
    int idx = blockIdx.x * 64 + threadIdx.x;
    int t = idx % SEQ, h = (idx / SEQ) % NH, b = idx / (SEQ * NH);
    int m = b * SEQ + t, qblk = t / BLK;
    float q[64], o[64];
    { const u32x4* qp = (const u32x4*)(Q + (size_t)m * 512 + h * 64);
#pragma unroll
      for (int c = 0; c < 8; ++c) { u32x4 r = qp[c];
#pragma unroll
          for (int e = 0; e < 4; ++e) { q[c * 8 + 2 * e] = __uint_as_float(r[e] << 16); q[c * 8 + 2 * e + 1] = __uint_as_float(r[e] & 0xffff0000u); } } }
#pragma unroll
    for (int d = 0; d < 64; ++d) o[d] = 0.f;
    float v1 = -INFINITY, v2 = -INFINITY, v3 = -INFINITY; int i1 = -1, i2 = -1, i3 = -1;
    const float* km = kmean + (size_t)(b * NH + h) * NB * 64;
    for (int j = 0; j < qblk; ++j) {
        float g = 0.f;
#pragma unroll
        for (int d = 0; d < 64; ++d) g += q[d] * km[j * 64 + d];
        if (g > v1) { v3 = v2; i3 = i2; v2 = v1; i2 = i1; v1 = g; i1 = j; }
        else if (g > v2) { v3 = v2; i3 = i2; v2 = g; i2 = j; }
        else if (g > v3) { v3 = g; i3 = j; }
    }
    float mx = -INFINITY, l = 0.f;
    for (int s = 0; s < 4; ++s) {
        int blk = (s == 0) ? i1 : (s == 1) ? i2 : (s == 2) ? i3 : qblk; if (blk < 0) continue;
        int nk = (s == 3) ? (t - qblk * BLK + 1) : BLK;
        const bf16* kp = Kb + (size_t)(b * SEQ + blk * BLK) * 512 + h * 64; const bf16* vp = Vb + (size_t)(b * SEQ + blk * BLK) * 512 + h * 64;
        for (int kk = 0; kk < nk; ++kk) {
            float sc = 0.f; const u32x4* kr = (const u32x4*)(kp + (size_t)kk * 512);
#pragma unroll
            for (int c = 0; c < 8; ++c) { u32x4 r = kr[c];
#pragma unroll
                for (int e = 0; e < 4; ++e) { sc += q[c * 8 + 2 * e] * __uint_as_float(r[e] << 16); sc += q[c * 8 + 2 * e + 1] * __uint_as_float(r[e] & 0xffff0000u); } }
            float mn = fmaxf(mx, sc), f = exp2f(mx - mn), p = exp2f(sc - mn);
            l = l * f + p; mx = mn;
            const u32x4* vr = (const u32x4*)(vp + (size_t)kk * 512);
#pragma unroll
            for (int c = 0; c < 8; ++c) { u32x4 r = vr[c];
#pragma unroll
                for (int e = 0; e < 4; ++e) { o[c * 8 + 2 * e] = o[c * 8 + 2 * e] * f + p * __uint_as_float(r[e] << 16); o[c * 8 + 2 * e + 1] = o[c * 8 + 2 * e + 1] * f + p * __uint_as_float(r[e] & 0xffff0000u); } }
        }
    }
    float il = 1.f / l; size_t ob = (size_t)m * 512 + h * 64;
#pragma unroll
    for (int d = 0; d < 64; ++d) ya[ob + d] = f2bf(o[d] * il * bf2f(sza[ob + d]));
}
__global__ void k_pool(const bf16* u, bf16* d) {
    size_t idx = (size_t)blockIdx.x * blockDim.x + threadIdx.x; if (idx >= (size_t)M * 512) return;
    int ch = idx & 511, m = (int)(idx >> 9), t = m % SEQ, g = ch >> 7, w = 2 << g, cnt = (t + 1 < w) ? t + 1 : w;
    float s = 0.f; for (int i = 0; i < cnt; ++i) s += bf2f(u[idx - (size_t)i * 512]);
    d[idx] = f2bf(s / (float)cnt - bf2f(u[idx]));
}
__global__ void k_final(float* out, const float* g) {
    int row = blockIdx.x * 4 + (threadIdx.x >> 6), lane = threadIdx.x & 63;
    f32x4* xr = (f32x4*)(out + (size_t)row * DM) + lane; f32x4 v[4]; float s = 0.f;
#pragma unroll
    for (int j = 0; j < 4; ++j) { v[j] = xr[64 * j]; s += v[j].x * v[j].x + v[j].y * v[j].y + v[j].z * v[j].z + v[j].w * v[j].w; }
#pragma unroll
    for (int o = 1; o < 64; o <<= 1) s += __shfl_xor(s, o);
    float rstd = rsqrtf(s * (1.f / DM) + EPS);
#pragma unroll
    for (int j = 0; j < 4; ++j) { f32x4 gg = *((const f32x4*)g + lane + 64 * j); xr[64 * j] = v[j] * rstd * gg; }
}

extern "C" void kernel_launch(void* const* d_in, const int* in_sizes, int n_in, void* d_out, int out_size, void* d_ws, size_t ws_size, hipStream_t stream) {
    const float *x = (const float*)d_in[0], *c = (const float*)d_in[1], *w_ada = (const float*)d_in[2], *b_ada = (const float*)d_in[3], *g_norm = (const float*)d_in[4],
                *w_in = (const float*)d_in[5], *w_grp = (const float*)d_in[6], *pscale = (const float*)d_in[7], *w_pu = (const float*)d_in[8], *w_au = (const float*)d_in[9],
                *w_out = (const float*)d_in[10], *g_final = (const float*)d_in[11];
    unsigned char* ws = (unsigned char*)d_ws; float* out = (float*)d_out;
    float* mod = (float*)(ws + WS_MOD); float* kmean = (float*)(ws + WS_KMEAN); float* tab = (float*)(ws + WS_ROPE);
    bf16 *H = (bf16*)(ws + WS_H), *D = (bf16*)(ws + WS_D), *YP = (bf16*)(ws + WS_YP), *U = (bf16*)(ws + WS_U), *SZP = (bf16*)(ws + WS_SZP), *Q = (bf16*)(ws + WS_Q), *YA = (bf16*)(ws + WS_YA),
         *K = (bf16*)(ws + WS_K), *V = (bf16*)(ws + WS_V), *MG = (bf16*)(ws + WS_MG), *SZA = (bf16*)(ws + WS_SZA), *SP = (bf16*)(ws + WS_SP), *SA = (bf16*)(ws + WS_SA);
    k_mod<<<12, 256, 0, stream>>>(c, w_ada, b_ada, mod);
    k_rope_tab<<<SEQ * 8 / 256, 256, 0, stream>>>(tab);
    k_h<<<M / 4, 256, 0, stream>>>(x, g_norm, mod, H);
    k_gemm<EpiIn><<<dim3(INW / 128, M / 128), 256, 0, stream>>>(H, DM, w_in, INW, DM, EpiIn{U, SZP, Q, K, V, SZA, SP, SA});
    k_rope<<<M * NH * 8 / 256, 256, 0, stream>>>(Q, K, tab);
    k_qscale<<<M * NH * 48 / 256, 256, 0, stream>>>(Q);
    k_kmean<<<BATCH * NH * NB * 64 / 256, 256, 0, stream>>>(K, kmean);
    k_pool<<<M * 512 / 256, 256, 0, stream>>>(U, D);
    for (int g = 0; g < 4; ++g)
        k_gemm<EpiGrp><<<dim3(1, M / 128), 256, 0, stream>>>(D + g * 128, 512, w_grp + (size_t)g * 128 * 128, 128, 128, EpiGrp{YP, SZP, pscale, g});
    k_attn<<<BATCH * NH * SEQ / 64, 64, 0, stream>>>(Q, K, V, kmean, SZA, YA);
    k_gemm<EpiPU><<<dim3(DM / 128, M / 128), 256, 0, stream>>>(YP, 512, w_pu, DM, 512, EpiPU{MG, SP});
    k_gemm<EpiAU><<<dim3(DM / 128, M / 128), 256, 0, stream>>>(YA, 512, w_au, DM, 512, EpiAU{MG, SA});
    k_gemm<EpiOut><<<dim3(DM / 128, M / 128), 256, 0, stream>>>(MG, DM, w_out, DM, DM, EpiOut{out, x, mod});
    k_final<<<M / 4, 256, 0, stream>>>(out, g_final);
}
```

```cpp
#include <hip/hip_runtime.h>
#include <cstdio>
#include <cstdint>
namespace pg8 {
#define PG8_LAS __attribute__((address_space(3)))
typedef unsigned short bf16_t;
typedef short bf16x8 __attribute__((ext_vector_type(8)));
typedef float f32x4 __attribute__((ext_vector_type(4)));
typedef unsigned u32x4 __attribute__((ext_vector_type(4)));
constexpr int BM = 256, BK = 64, HALF = 128, HTB = HALF * BK * 2  , STAGE_BYTES = 8 * HTB, NXCD = 8, WGM = 8;

__host__ __device__ __forceinline__ int lds_byte(int r, int c) { const int st = (r >> 4) * 2 + (c >> 5), rr = r & 15, cc = c & 31, ob = rr * 64 + cc * 2; return st * 1024 + (ob ^ (((ob >> 9) & 1) << 5)); }
__host__ __device__ __forceinline__ void stage_rc(int b, int& R, int& C) { const int st = b / 1024, sb = b % 1024, swz = sb ^ (((sb >> 9) & 1) << 5); R = (st >> 1) * 16 + swz / 64; C = (st & 1) * 32 + (swz % 64) / 2; }
__host__ __device__ __forceinline__ int perm32(int rho) { const int n = rho >> 4, i = rho & 15; return 8 * (i >> 2) + 4 * n + (i & 3); }

struct Unit { int pm, pn; };
struct Gemm { const bf16_t* A; const bf16_t* Bt; int M, N, K, lda, ldb, akoff; };

struct StaticOrder {
    int nM, nN, nwg, G, c;
    __host__ __device__ void init(int M, int N, int G_, int c_) { nM = M / BM; nN = N / BM; nwg = nM * nN; G = G_; c = c_; }
    __host__ __device__ bool next(int i, Unit& u) const {
        const long L = (long)i * G + c; if (L >= nwg) return false;
        int wgid = (int)L; { const int q = nwg / NXCD, r = nwg % NXCD, xcd = wgid % NXCD, off = wgid / NXCD; wgid = (xcd < r ? xcd * (q + 1) : r * (q + 1) + (xcd - r) * q) + off; }
        const int nig = WGM * nN, gid = wgid / nig, fm = gid * WGM, gsz = (nM - fm) < WGM ? (nM - fm) : WGM;
        u.pm = fm + ((wgid % nig) % gsz); u.pn = (wgid % nig) / gsz; return true;
    }
    __device__ __forceinline__ void a_ready(const Unit&) const {}
    __device__ __forceinline__ void done(const Unit&) const {}
};

constexpr int SEQ_ = 8192;
constexpr float C2_ = 0.125f * 1.4426950408889634f;
__device__ __forceinline__ unsigned cvt_pk_bf16(float lo, float hi) { unsigned r; asm volatile("v_cvt_pk_bf16_f32 %0, %1, %2" : "=v"(r) : "v"(lo), "v"(hi)); return r; }
__device__ __forceinline__ float bflo(unsigned w) { return __uint_as_float(w << 16); }
__device__ __forceinline__ float bfhi(unsigned w) { return __uint_as_float(w & 0xffff0000u); }
__device__ __forceinline__ float fsigm(float z) { return __builtin_amdgcn_rcpf(1.f + __expf(-z)); }
__device__ __forceinline__ float fsilu(float z) { return z * fsigm(z); }
__device__ __forceinline__ u32x4 pack8(const f32x4& v0, const f32x4& v1) { u32x4 w; w.x = cvt_pk_bf16(v0[0], v0[1]); w.y = cvt_pk_bf16(v0[2], v0[3]); w.z = cvt_pk_bf16(v1[0], v1[1]); w.w = cvt_pk_bf16(v1[2], v1[3]); return w; }

struct EpiIn {
    static constexpr bool PERM = true, AFTER_DRAIN = false;
    bf16_t *u, *szp, *q, *k, *v, *sza, *sp, *sa; const float* tab;
    __device__ __forceinline__ void operator()(const f32x4 (&acc)[2][2][4][2], const Unit& un, int wr, int wc, int fr, int fq) const {
        const int pn = un.pn; bf16_t* dst; int ld, ct, mode;
        if (pn < 2) { dst = u; ld = 512; ct = pn; mode = 0; }
        else if (pn < 4) { dst = szp; ld = 512; ct = pn - 2; mode = 1; }
        else if (pn < 6) { dst = q; ld = 512; ct = pn - 4; mode = 3; }
        else if (pn < 8) { dst = k; ld = 512; ct = pn - 6; mode = 4; }
        else if (pn < 10) { dst = v; ld = 512; ct = pn - 8; mode = 0; }
        else if (pn < 12) { dst = sza; ld = 512; ct = pn - 10; mode = 1; }
        else if (pn < 16) { dst = sp; ld = 1024; ct = pn - 12; mode = 2; }
        else { dst = sa; ld = 1024; ct = pn - 16; mode = 2; }
        const int row0 = un.pm * BM + wr * 64 + fr, col0 = ct * 256 + wc * 32 + 8 * fq;
        const bool rope = (mode >= 3) && ((wc & 1) == 0);
        const float sgn = (fq == 0) ? -1.f : 1.f; const bool rl = fq < 2;
#pragma unroll
        for (int ai = 0; ai < 2; ++ai)
#pragma unroll
            for (int m = 0; m < 4; ++m) {
                const int row = row0 + ai * HALF + m * 16;
                f32x4 cs0 = {1.f, 1.f, 1.f, 1.f}, cs1 = cs0, sn0 = {0.f, 0.f, 0.f, 0.f}, sn1 = sn0;
                if (rope) { const float* t = tab + (size_t)(row & (SEQ_ - 1)) * 16; cs0 = *(const f32x4*)t; cs1 = *(const f32x4*)(t + 4); sn0 = *(const f32x4*)(t + 8); sn1 = *(const f32x4*)(t + 12); }
#pragma unroll
                for (int bj = 0; bj < 2; ++bj) {
                    f32x4 v0 = acc[ai][bj][m][0], v1 = acc[ai][bj][m][1];
                    if (mode == 1) {
#pragma unroll
                        for (int e = 0; e < 4; ++e) { v0[e] = fsilu(v0[e]); v1[e] = fsilu(v1[e]); }
                    } else if (mode == 2) {
#pragma unroll
                        for (int e = 0; e < 4; ++e) { v0[e] = fsigm(v0[e]); v1[e] = fsigm(v1[e]); }
                    } else if (rope) {
#pragma unroll
                        for (int e = 0; e < 4; ++e) {
                            const float p0 = __shfl_xor(v0[e], 16), p1 = __shfl_xor(v1[e], 16);
                            const float r0 = v0[e] * cs0[e] + sgn * p0 * sn0[e], r1 = v1[e] * cs1[e] + sgn * p1 * sn1[e];
                            v0[e] = rl ? r0 : v0[e]; v1[e] = rl ? r1 : v1[e]; }
                    }
                    if (mode == 3) { v0 = v0 * C2_; v1 = v1 * C2_; }
                    *(u32x4*)(dst + (size_t)row * ld + col0 + bj * HALF) = pack8(v0, v1);
                }
            }
    }
};
struct EpiGate {
    static constexpr bool PERM = true, AFTER_DRAIN = false;
    bf16_t* out; const bf16_t* mul; const bf16_t* add; const float* cs; int ld;
    __device__ __forceinline__ void operator()(const f32x4 (&acc)[2][2][4][2], const Unit& un, int wr, int wc, int fr, int fq) const {
        const int row0 = un.pm * BM + wr * 64 + fr, col0 = un.pn * BM + wc * 32 + 8 * fq;
        f32x4 c0[2], c1[2];
#pragma unroll
        for (int bj = 0; bj < 2; ++bj) { c0[bj] = cs ? *(const f32x4*)(cs + col0 + bj * HALF) : (f32x4){1.f, 1.f, 1.f, 1.f}; c1[bj] = cs ? *(const f32x4*)(cs + col0 + bj * HALF + 4) : (f32x4){1.f, 1.f, 1.f, 1.f}; }
#pragma unroll
        for (int ai = 0; ai < 2; ++ai)
#pragma unroll
            for (int m = 0; m < 4; ++m) {
                const size_t ro = (size_t)(row0 + ai * HALF + m * 16) * ld + col0;
#pragma unroll
                for (int bj = 0; bj < 2; ++bj) {
                    const u32x4 mw = *(const u32x4*)(mul + ro + bj * HALF);
                    f32x4 v0 = acc[ai][bj][m][0] * (f32x4){bflo(mw.x), bfhi(mw.x), bflo(mw.y), bfhi(mw.y)} * c0[bj];
                    f32x4 v1 = acc[ai][bj][m][1] * (f32x4){bflo(mw.z), bfhi(mw.z), bflo(mw.w), bfhi(mw.w)} * c1[bj];
                    if (add) { const u32x4 aw = *(const u32x4*)(add + ro + bj * HALF);
                        v0 = v0 + (f32x4){bflo(aw.x), bfhi(aw.x), bflo(aw.y), bfhi(aw.y)}; v1 = v1 + (f32x4){bflo(aw.z), bfhi(aw.z), bflo(aw.w), bfhi(aw.w)}; }
                    *(u32x4*)(out + ro + bj * HALF) = pack8(v0, v1);
                }
            }
    }
};
struct EpiOut {
    static constexpr bool PERM = false, AFTER_DRAIN = false;
    float* out; const float* x; const float* mod;
    __device__ __forceinline__ void operator()(const f32x4 (&acc)[2][2][4][2], const Unit& un, int wr, int wc, int fr, int fq) const {
        const int row0 = un.pm * BM + wr * 64 + fr, col0 = un.pn * BM + wc * 32 + 4 * fq;
        const float* gate = mod + (size_t)((un.pm * BM) / SEQ_) * 3072 + 2048;
        f32x4 gv[2][2];
#pragma unroll
        for (int bj = 0; bj < 2; ++bj)
#pragma unroll
            for (int n = 0; n < 2; ++n) gv[bj][n] = *(const f32x4*)(gate + col0 + bj * HALF + n * 16);
#pragma unroll
        for (int ai = 0; ai < 2; ++ai)
#pragma unroll
            for (int m = 0; m < 4; ++m) {
                const size_t ro = (size_t)(row0 + ai * HALF + m * 16) * 1024 + col0;
#pragma unroll
                for (int bj = 0; bj < 2; ++bj)
#pragma unroll
                    for (int n = 0; n < 2; ++n) *(f32x4*)(out + ro + bj * HALF + n * 16) = *(const f32x4*)(x + ro + bj * HALF + n * 16) + gv[bj][n] * acc[ai][bj][m][n];
            }
    }
};

template <class Epi, class Sched, bool ALIGN_EPI = false, bool SP2 = false>
__device__ __forceinline__ void gemm_phase(PG8_LAS unsigned char* lds, const Gemm g, const Sched& S, const Epi& E) {
    const int tid = threadIdx.x, wid = __builtin_amdgcn_readfirstlane(tid >> 6), lane = tid & 63, wr = wid >> 2, wc = wid & 3, fr = lane & 15, fq = lane >> 4;
    const int K = g.K, nt = K / BK;
    unsigned voffA[2], voffB[2];
#pragma unroll
    for (int i = 0; i < 2; ++i) { int R, C; stage_rc(tid * 16 + i * 8192, R, C); const int Rb = Epi::PERM ? ((R & ~31) + perm32(R & 31)) : R;
        voffA[i] = (unsigned)(R * g.lda + C) * 2u; voffB[i] = (unsigned)(Rb * g.ldb + C) * 2u; }
    const size_t kstep = (size_t)(BK * 2);
    const size_t hstepA = (size_t)HALF * g.lda * 2, hstepB = (size_t)HALF * g.ldb * 2;
    const size_t tstepA = 2 * hstepA, tstepB = 2 * hstepB;
    const unsigned ldsw = (unsigned)wid * 1024u;
    const int aoff = lds_byte(wr * 64 + fr, fq * 8), boff = lds_byte(wc * 32 + fr, fq * 8);
#define PG8_SA(b, h) (((b) * 2 + (h)) * HTB)
#define PG8_SB(b, h) ((4 + (b) * 2 + (h)) * HTB)
#define PG8_STAGE(bufoff, gbase, voff) do { _Pragma("unroll") for (int _i = 0; _i < 2; ++_i) \
        __builtin_amdgcn_global_load_lds((const unsigned*)((const char*)(gbase) + (voff)[_i]), (PG8_LAS unsigned*)(lds + (bufoff) + ldsw + _i * 8192), 16, 0, 0); } while (0)
#define PG8_LDA(dst, b, h) do { _Pragma("unroll") for (int m = 0; m < 4; ++m) _Pragma("unroll") for (int k = 0; k < 2; ++k) dst[m][k] = *(const PG8_LAS bf16x8*)(lds + PG8_SA(b, h) + aoff + m * 2048 + k * 1024); } while (0)
#define PG8_LDB(dst, b, h) do { _Pragma("unroll") for (int n = 0; n < 2; ++n) _Pragma("unroll") for (int k = 0; k < 2; ++k) dst[n][k] = *(const PG8_LAS bf16x8*)(lds + PG8_SB(b, h) + boff + n * 2048 + k * 1024); } while (0)
#define PG8_MMA(ai, bj, At, Bt) do { __builtin_amdgcn_s_setprio(1); _Pragma("unroll") for (int m = 0; m < 4; ++m) _Pragma("unroll") for (int n = 0; n < 2; ++n) _Pragma("unroll") for (int k = 0; k < 2; ++k) \
        acc[ai][bj][m][n] = __builtin_amdgcn_mfma_f32_16x16x32_bf16(Bt[n][k], At[m][k], acc[ai][bj][m][n], 0, 0, 0); __builtin_amdgcn_s_setprio(0); } while (0)
#define PG8_WAIT_V(n) asm volatile("s_waitcnt vmcnt(" #n ")" ::: "memory")
#define PG8_WAIT_L(n) asm volatile("s_waitcnt lgkmcnt(" #n ")" ::: "memory")
#define PG8_BAR __builtin_amdgcn_s_barrier()
#define PG8_SCHED __builtin_amdgcn_sched_barrier(0)
    Unit cur, nxt; int ui = 0;
    if (!S.next(0, cur)) return;
    f32x4 acc[2][2][4][2];
#pragma unroll
    for (int a = 0; a < 2; ++a)
#pragma unroll
        for (int b = 0; b < 2; ++b)
#pragma unroll
            for (int m = 0; m < 4; ++m)
#pragma unroll
                for (int n = 0; n < 2; ++n) acc[a][b][m][n] = (f32x4){0.f, 0.f, 0.f, 0.f};
    bf16x8 At[4][2], B0[2][2], B1[2][2];
    const char* cA = (const char*)g.A + (size_t)cur.pm * tstepA + (size_t)cur.pn * g.akoff * 2; const char* cB = (const char*)g.Bt + (size_t)cur.pn * tstepB;
    S.a_ready(cur);
    if constexpr (SP2) {
        PG8_STAGE(PG8_SB(0, 0), cB, voffB); PG8_STAGE(PG8_SB(0, 1), cB + hstepB, voffB); PG8_STAGE(PG8_SA(0, 0), cA, voffA); PG8_STAGE(PG8_SA(0, 1), cA + hstepA, voffA);
        if (wr == 1) PG8_BAR;
        PG8_WAIT_V(2); PG8_BAR;
        PG8_STAGE(PG8_SB(1, 0), cB + kstep, voffB); PG8_STAGE(PG8_SA(1, 0), cA + kstep, voffA); PG8_STAGE(PG8_SB(1, 1), cB + hstepB + kstep, voffB);
        PG8_WAIT_V(6); PG8_BAR;
    } else {
        PG8_STAGE(PG8_SB(0, 0), cB, voffB); PG8_STAGE(PG8_SA(0, 0), cA, voffA); PG8_STAGE(PG8_SB(0, 1), cB + hstepB, voffB); PG8_STAGE(PG8_SA(0, 1), cA + hstepA, voffA);
        if (wr == 1) PG8_BAR;
        PG8_WAIT_V(4); PG8_BAR;
        PG8_STAGE(PG8_SB(1, 0), cB + kstep, voffB); PG8_STAGE(PG8_SA(1, 0), cA + kstep, voffA); PG8_STAGE(PG8_SB(1, 1), cB + hstepB + kstep, voffB);
        PG8_WAIT_V(6); PG8_BAR;
    }
    for (;;) {
        const bool has_next = S.next(ui + 1, nxt);
        const char* nA = has_next ? (const char*)g.A + (size_t)nxt.pm * tstepA + (size_t)nxt.pn * g.akoff * 2 : cA; const char* nB = has_next ? (const char*)g.Bt + (size_t)nxt.pn * tstepB : cB;
        for (int t = 0; t < nt; t += 2) {
            const bool last = (t == nt - 2);
            const char* a1 = cA + (size_t)(t + 1) * kstep;
            const char* a2 = last ? nA : cA + (size_t)(t + 2) * kstep; const char* b2 = last ? nB : cB + (size_t)(t + 2) * kstep;
            const char* a3 = a2 + kstep; const char* b3 = b2 + kstep;
            if (last && has_next) S.a_ready(nxt);
            if constexpr (SP2) {
            PG8_LDB(B0, 0, 0); PG8_LDB(B1, 0, 1); PG8_SCHED; PG8_LDA(At, 0, 0); PG8_STAGE(PG8_SA(1, 1), a1 + hstepA, voffA);
            PG8_WAIT_V(8); PG8_WAIT_L(0); PG8_BAR; PG8_MMA(0, 0, At, B0); PG8_MMA(0, 1, At, B1); PG8_BAR; PG8_SCHED;
            PG8_LDA(At, 0, 1); PG8_STAGE(PG8_SB(0, 0), b2, voffB); PG8_STAGE(PG8_SB(0, 1), b2 + hstepB, voffB); PG8_STAGE(PG8_SA(0, 0), a2, voffA);
            PG8_WAIT_V(8); PG8_WAIT_L(0); PG8_BAR; PG8_MMA(1, 0, At, B0); PG8_MMA(1, 1, At, B1); PG8_BAR; PG8_SCHED;
            PG8_LDB(B0, 1, 0); PG8_LDB(B1, 1, 1); PG8_SCHED; PG8_LDA(At, 1, 0); PG8_STAGE(PG8_SA(0, 1), a2 + hstepA, voffA);
            PG8_WAIT_V(8); PG8_WAIT_L(0); PG8_BAR; PG8_MMA(0, 0, At, B0); PG8_MMA(0, 1, At, B1); PG8_BAR; PG8_SCHED;
            PG8_LDA(At, 1, 1); PG8_STAGE(PG8_SB(1, 0), b3, voffB); PG8_STAGE(PG8_SB(1, 1), b3 + hstepB, voffB); PG8_STAGE(PG8_SA(1, 0), a3, voffA);
            PG8_WAIT_V(8); PG8_WAIT_L(0); PG8_BAR; PG8_MMA(1, 0, At, B0); PG8_MMA(1, 1, At, B1); PG8_BAR; PG8_SCHED;
            } else {
            PG8_LDB(B0, 0, 0); PG8_SCHED; PG8_LDA(At, 0, 0); PG8_STAGE(PG8_SA(1, 1), a1 + hstepA, voffA);
            PG8_WAIT_L(8); PG8_BAR; PG8_WAIT_L(0); PG8_MMA(0, 0, At, B0); PG8_BAR; PG8_SCHED;
            PG8_LDB(B1, 0, 1); PG8_STAGE(PG8_SB(0, 0), b2, voffB);
            PG8_BAR; PG8_WAIT_L(0); PG8_MMA(0, 1, At, B1); PG8_BAR;
            PG8_LDA(At, 0, 1); PG8_STAGE(PG8_SA(0, 0), a2, voffA);
            PG8_BAR; PG8_WAIT_L(0); PG8_MMA(1, 0, At, B0); PG8_BAR; PG8_SCHED;
            PG8_STAGE(PG8_SB(0, 1), b2 + hstepB, voffB);
            PG8_WAIT_V(6); PG8_BAR; PG8_MMA(1, 1, At, B1); PG8_BAR;
            PG8_LDB(B0, 1, 0); PG8_SCHED; PG8_LDA(At, 1, 0); PG8_STAGE(PG8_SA(0, 1), a2 + hstepA, voffA);
            PG8_WAIT_L(8); PG8_BAR; PG8_WAIT_L(0); PG8_MMA(0, 0, At, B0); PG8_BAR; PG8_SCHED;
            PG8_LDB(B1, 1, 1); PG8_STAGE(PG8_SB(1, 0), b3, voffB);
            PG8_BAR; PG8_WAIT_L(0); PG8_MMA(0, 1, At, B1); PG8_BAR;
            PG8_LDA(At, 1, 1); PG8_STAGE(PG8_SA(1, 0), a3, voffA);
            PG8_BAR; PG8_WAIT_L(0); PG8_MMA(1, 0, At, B0); PG8_BAR; PG8_SCHED;
            PG8_STAGE(PG8_SB(1, 1), b3 + hstepB, voffB);
            PG8_WAIT_V(6); PG8_BAR; PG8_MMA(1, 1, At, B1); PG8_BAR;
            }
        }
        if constexpr (ALIGN_EPI) { if (wr == 0) PG8_BAR; }
        if constexpr (!Epi::AFTER_DRAIN) { E(acc, cur, wr, wc, fr, fq); S.done(cur); }
        if (!has_next) break;
#pragma unroll
        for (int a = 0; a < 2; ++a)
#pragma unroll
            for (int b = 0; b < 2; ++b)
#pragma unroll
                for (int m = 0; m < 4; ++m)
#pragma unroll
                    for (int n = 0; n < 2; ++n) acc[a][b][m][n] = (f32x4){0.f, 0.f, 0.f, 0.f};
        cur = nxt; cA = nA; cB = nB; ++ui;
        if constexpr (ALIGN_EPI) { if (wr == 1) PG8_BAR; }
    }
    PG8_WAIT_V(0);
    if constexpr (!ALIGN_EPI) { if (wr == 0) PG8_BAR; }
    PG8_BAR;
    if constexpr (Epi::AFTER_DRAIN) { E.fused(acc, cur, wr, wc, fr, fq, lds, wid, lane); S.done(cur); }
#undef PG8_SA
#undef PG8_SB
#undef PG8_STAGE
#undef PG8_LDA
#undef PG8_LDB
#undef PG8_MMA
#undef PG8_WAIT_V
#undef PG8_WAIT_L
#undef PG8_BAR
#undef PG8_SCHED
}

}
#define GAS __attribute__((address_space(1)))
#define LAS __attribute__((address_space(3)))
typedef unsigned short bf16;
typedef unsigned v4u __attribute__((ext_vector_type(4)));
typedef float f32x4 __attribute__((ext_vector_type(4)));
typedef short bf16x8 __attribute__((ext_vector_type(8)));
typedef GAS unsigned gu32;
typedef GAS unsigned long long gu64;
#define RLX_AGENT __ATOMIC_RELAXED, __HIP_MEMORY_SCOPE_AGENT
#define LDS_WAIT() asm volatile("s_waitcnt lgkmcnt(0)" ::: "memory")
#define VM_WAIT() asm volatile("s_waitcnt vmcnt(0)" ::: "memory")
__device__ __forceinline__ unsigned long long rt() { return __builtin_amdgcn_s_memrealtime(); }
__device__ __forceinline__ unsigned f2bf(float f) { unsigned u = __builtin_bit_cast(unsigned, f); return (u + 0x7fffu + ((u >> 16) & 1u)) >> 16; }
__device__ __forceinline__ unsigned pk2(float lo, float hi) { return f2bf(lo) | (f2bf(hi) << 16); }

#define XB_TMO      128
#define XB_XCNT(j)  (256  + 64 * (j))
#define XB_XSUB(j)  (1280 + 64 * (j))
#define XB_XGEN(j)  (2304 + 64 * (j))
#define XB_TOP      3328
#define XB_TOPGEN   3392
#define XCD_BAR_WORDS 3456
#define XB_SPIN_CAP (1u << 18)

__device__ __forceinline__ unsigned xb_ld(unsigned* p)              { return __hip_atomic_load(p, __ATOMIC_RELAXED, __HIP_MEMORY_SCOPE_AGENT); }
__device__ __forceinline__ unsigned xb_add(unsigned* p, unsigned v) { return __hip_atomic_fetch_add(p, v, __ATOMIC_RELAXED, __HIP_MEMORY_SCOPE_AGENT); }
__device__ __forceinline__ unsigned xb_xcc_id() { return (unsigned)__builtin_amdgcn_s_getreg((3 << 11) | 20) & 0xFu; }
#define XB_SPIN(cond, bar) do { unsigned _sp = 0; while (cond) { __builtin_amdgcn_s_sleep(1); \
    if ((++_sp & 255u) == 0u) { if (xb_ld(&(bar)[XB_TMO])) break; if (_sp > XB_SPIN_CAP) { atomicAdd(&(bar)[XB_TMO], 1u); break; } } } } while (0)

struct XcdBarrier {
    unsigned* bar; unsigned x;
    volatile LAS unsigned* st;
};

__device__ __forceinline__ XcdBarrier xcd_barrier_post(unsigned* bar, volatile LAS unsigned* st) {
    XcdBarrier b; b.bar = bar; b.x = xb_xcc_id(); b.st = st;
    if (threadIdx.x == 0) (void)xb_add(&bar[XB_XCNT(b.x)], 1u);
    return b;
}
__device__ __forceinline__ void xcd_barrier_complete(unsigned* bar, unsigned x, unsigned& nloc, unsigned& nx) {
    const unsigned G = gridDim.x * gridDim.y * gridDim.z;
    unsigned sum, cnt, mine, sp = 0u;
    for (;;) {
        sum = 0u; cnt = 0u; mine = 0u;
#pragma unroll
        for (unsigned j = 0; j < 16; ++j) { const unsigned c = xb_ld(&bar[XB_XCNT(j)]); sum += c; cnt += (c > 0u) ? 1u : 0u; mine = (j == x) ? c : mine; }
        if (sum == G) break;
        __builtin_amdgcn_s_sleep(1);
        if ((++sp & 255u) == 0u) { if (xb_ld(&bar[XB_TMO])) break; if (sp > XB_SPIN_CAP) { atomicAdd(&bar[XB_TMO], 1u); break; } }
    }
    nloc = mine > 0u ? mine : 1u; nx = cnt > 0u ? cnt : 1u;
}

__device__ __forceinline__ void xcd_barrier(const XcdBarrier& b) {
    asm volatile("s_waitcnt vmcnt(0)" ::: "memory");
    __syncthreads();
    if (threadIdx.x == 0) {
        unsigned* bar = b.bar;
        __builtin_amdgcn_s_waitcnt(0);
        unsigned nloc = b.st[0], nx = b.st[1];
        if (nloc == 0u) { xcd_barrier_complete(bar, b.x, nloc, nx); b.st[0] = nloc; b.st[1] = nx; }
        const unsigned old = xb_add(&bar[XB_XSUB(b.x)], 1u);
        const unsigned gen = old / nloc;
        if (old + 1u == (gen + 1u) * nloc) {
            __builtin_amdgcn_fence(__ATOMIC_RELEASE, "agent");
            asm volatile("s_waitcnt vmcnt(0)" ::: "memory");
            const unsigned og = xb_add(&bar[XB_TOP], 1u);
            const unsigned tg = og / nx;
            if (og + 1u == (tg + 1u) * nx) xb_add(&bar[XB_TOPGEN], 1u);
            else XB_SPIN(xb_ld(&bar[XB_TOPGEN]) == tg, bar);
            __builtin_amdgcn_fence(__ATOMIC_ACQUIRE, "agent");
            xb_add(&bar[XB_XGEN(b.x)], 1u);
            asm volatile("s_waitcnt vmcnt(0)" ::: "memory");
        } else {
            XB_SPIN(xb_ld(&bar[XB_XGEN(b.x)]) == gen, bar);
            __builtin_amdgcn_fence(__ATOMIC_ACQUIRE, "agent");
            asm volatile("s_waitcnt vmcnt(0)" ::: "memory");
        }
    }
    __syncthreads();
}

constexpr int DM = 1024, BATCH = 4, SEQ = 8192, M = BATCH * SEQ, NH = 8, HD = 64, BLK = 256, NB = SEQ / BLK, INW = 5120;
constexpr float EPS = 1e-6f;
constexpr int NWAVES = 8;
constexpr size_t MiB = 1u << 20;
constexpr size_t WS_CTL = 0, CTL_ZERO_BYTES = 1 * MiB;
constexpr size_t WS_MOD = 1 * MiB, WS_KMEAN = 1 * MiB + 256 * 1024, WS_ROPE = 2 * MiB;
constexpr size_t WS_WIN = 4 * MiB, WS_WPU = 14 * MiB, WS_WAU = 15 * MiB, WS_WOUT = 16 * MiB, WS_WG = 18 * MiB;
constexpr size_t WS_H = 32 * MiB, WS_D = 32 * MiB, WS_YP = 64 * MiB;
constexpr size_t WS_U = 96 * MiB, WS_SZP = 128 * MiB, WS_Q = 160 * MiB, WS_YA = 160 * MiB, WS_K = 192 * MiB, WS_V = 224 * MiB, WS_MG = 192 * MiB;
constexpr size_t WS_SZA = 256 * MiB, WS_SP = 288 * MiB, WS_SA = 352 * MiB, WS_END = 416 * MiB;
constexpr int CW_BAR = 4096;
constexpr int RING_OFF = 0, RING_BYTES = 131072, LDSCTL_OFF = RING_BYTES, MISC_OFF = LDSCTL_OFF + 320, LDS_BYTES = 147456;

__device__ __forceinline__ float bf2f(bf16 v) { return __uint_as_float((unsigned)v << 16); }
__device__ __forceinline__ float wave_sum(float v) {
#pragma unroll
    for (int o = 1; o < 64; o <<= 1) v += __shfl_xor(v, o);
    return v;
}
__device__ __forceinline__ void p0_transpose_item(const float* W, int K, int N, bf16* WT, int row_off, LAS float* scr, int item, int lane) {
    const int nblk = N / 32, kb = item / nblk, nb = item % nblk, k0 = 64 * kb, n0 = 32 * nb;
#pragma unroll 8
    for (int i = 0; i < 32; ++i) { const int kk = 2 * i + (lane >> 5); scr[kk * 33 + (lane & 31)] = W[(size_t)(k0 + kk) * N + n0 + (lane & 31)]; }
    LDS_WAIT(); asm volatile("" ::: "memory");
    const int c = lane & 7;
#pragma unroll
    for (int j = 0; j < 4; ++j) { const int n = (lane >> 3) + 8 * j; const LAS float* s = scr + (8 * c) * 33 + n;
        v4u o; o.x = pk2(s[0 * 33], s[1 * 33]); o.y = pk2(s[2 * 33], s[3 * 33]); o.z = pk2(s[4 * 33], s[5 * 33]); o.w = pk2(s[6 * 33], s[7 * 33]);
        *(GAS v4u*)(WT + (size_t)(row_off + n0 + n) * K + k0 + 8 * c) = o; }
    LDS_WAIT(); asm volatile("" ::: "memory");
}

struct Args { const float* in[12]; float* out; unsigned char* ws; };

__global__ void __launch_bounds__(NWAVES * 64, 2) mk_fwd(Args args) {
    extern __shared__ __attribute__((aligned(16))) unsigned char lds[];
    LAS unsigned char* L = (LAS unsigned char*)lds;
    volatile LAS unsigned* MISC = (volatile LAS unsigned*)(L + MISC_OFF);
    const int tid = threadIdx.x, lane = tid & 63, wave = __builtin_amdgcn_readfirstlane(tid >> 6);
    const int G = gridDim.x, bx = blockIdx.x;
    const int vcu = (G % 8 == 0) ? (bx % 8) * (G / 8) + bx / 8 : bx;
    const int gw = vcu * NWAVES + wave, NGW = G * NWAVES;
    const long gt = (long)vcu * (NWAVES * 64) + tid, NGT = (long)G * NWAVES * 64;
    unsigned char* ws = args.ws;
    const float *x = args.in[0], *cvec = args.in[1], *w_ada = args.in[2], *b_ada = args.in[3], *g_norm = args.in[4], *w_in = args.in[5], *w_grp = args.in[6], *pscale = args.in[7],
                *w_pu = args.in[8], *w_au = args.in[9], *w_out = args.in[10], *g_final = args.in[11];
    float* out = args.out;
    unsigned* ctl = (unsigned*)(ws + WS_CTL);
    float* mod = (float*)(ws + WS_MOD); float* kmean = (float*)(ws + WS_KMEAN); float* tab = (float*)(ws + WS_ROPE);
    bf16 *Win_t = (bf16*)(ws + WS_WIN), *Wpu_t = (bf16*)(ws + WS_WPU), *Wau_t = (bf16*)(ws + WS_WAU), *Wout_t = (bf16*)(ws + WS_WOUT), *Wg_t = (bf16*)(ws + WS_WG);
    bf16 *H = (bf16*)(ws + WS_H), *Dp = (bf16*)(ws + WS_D), *YP = (bf16*)(ws + WS_YP), *U = (bf16*)(ws + WS_U), *SZP = (bf16*)(ws + WS_SZP), *Q = (bf16*)(ws + WS_Q), *YA = (bf16*)(ws + WS_YA),
         *Kb = (bf16*)(ws + WS_K), *Vb = (bf16*)(ws + WS_V), *MG = (bf16*)(ws + WS_MG), *SZA = (bf16*)(ws + WS_SZA), *SP = (bf16*)(ws + WS_SP), *SA = (bf16*)(ws + WS_SA);

    for (int u = tid; u < (LDS_BYTES - LDSCTL_OFF) / 4; u += NWAVES * 64) ((LAS unsigned*)(L + LDSCTL_OFF))[u] = 0u;
    __syncthreads();
    XcdBarrier bar = xcd_barrier_post(ctl + CW_BAR, MISC + 8);
#define GRID_BAR() xcd_barrier(bar)

    {
        LAS float* red = (LAS float*)(L + RING_OFF);
        for (int it = bx; it < 192; it += G) {
            const int n0 = it * 16, ni = tid & 15, ks = tid >> 4;
            float a0 = 0.f, a1 = 0.f, a2 = 0.f, a3 = 0.f;
#pragma unroll 8
            for (int j = 0; j < 32; ++j) { const int k = ks + 32 * j; const float w = w_ada[(size_t)k * 3072 + n0 + ni];
                a0 += cvec[k] * w; a1 += cvec[1024 + k] * w; a2 += cvec[2048 + k] * w; a3 += cvec[3072 + k] * w; }
            red[(0 * 32 + ks) * 16 + ni] = a0; red[(1 * 32 + ks) * 16 + ni] = a1; red[(2 * 32 + ks) * 16 + ni] = a2; red[(3 * 32 + ks) * 16 + ni] = a3;
            __syncthreads();
            if (tid < 64) { const int b = tid >> 4; float s = b_ada[n0 + ni];
                for (int q = 0; q < 32; ++q) s += red[(b * 32 + q) * 16 + ni];
                mod[b * 3072 + n0 + ni] = s; }
            __syncthreads();
        }
        for (long idx = gt; idx < SEQ * 8; idx += NGT) {
            const int pos = (int)(idx >> 3), i = (int)(idx & 7);
            const float invf[8] = {1.0f, 0.1939227432012558f, 0.03760603070259094f, 0.007292664609849453f, 0.0014142135623842478f, 0.00027424818836152554f, 5.318296098266728e-05f, 1.0313386155758053e-05f};
            float inv = invf[0];
#pragma unroll
            for (int q = 1; q < 8; ++q) inv = (i == q) ? invf[q] : inv;
            const float angf = (float)pos * inv;
            const double ang = (double)angf, kq = rint(ang * 0.15915494309189535);
            double r = fma(-kq, 6.283185307179586, ang); r = fma(-kq, 2.4492935982947064e-16, r);
            const float rf = (float)r;
            tab[pos * 16 + i] = cosf(rf); tab[pos * 16 + 8 + i] = sinf(rf);
        }
        LAS float* scr = (LAS float*)(L + RING_OFF + wave * 16384);
        constexpr int I_IN = (DM / 64) * (INW / 32), I_PU = (512 / 64) * (DM / 32), I_OUT = (DM / 64) * (DM / 32);
        constexpr int NITEMS = I_IN + 2 * I_PU + I_OUT;
        for (int it = gw; it < NITEMS; it += NGW) {
            int r = it;
            if (r < I_IN) { p0_transpose_item(w_in, DM, INW, Win_t, 0, scr, r, lane); continue; } r -= I_IN;
            if (r < I_PU) { p0_transpose_item(w_pu, 512, DM, Wpu_t, 0, scr, r, lane); continue; } r -= I_PU;
            if (r < I_PU) { p0_transpose_item(w_au, 512, DM, Wau_t, 0, scr, r, lane); continue; } r -= I_PU;
            p0_transpose_item(w_out, DM, DM, Wout_t, 0, scr, r, lane);
        }
        for (long idx = gt; idx < 512 * 256; idx += NGT) {
            const int n = (int)(idx >> 8), kl = (int)(idx & 255), g = n >> 7, kg = (n >> 8) * 2 + (kl >> 7);
            const float v = (kg == g) ? w_grp[((size_t)g * 128 + (kl & 127)) * 128 + (n & 127)] : 0.f;
            Wg_t[idx] = (bf16)f2bf(v);
        }
    }
    GRID_BAR();
    for (int row = gw; row < M; row += NGW) {
        const int b = row / SEQ;
        const GAS f32x4* xr = (const GAS f32x4*)(x + (size_t)row * DM) + lane;
        f32x4 v[4]; float s = 0.f;
#pragma unroll
        for (int j = 0; j < 4; ++j) { v[j] = xr[64 * j]; s += (v[j].x * v[j].x + v[j].y * v[j].y) + (v[j].z * v[j].z + v[j].w * v[j].w); }
        const float rstd = rsqrtf(wave_sum(s) * (1.f / DM) + EPS);
        const float* shift = mod + (size_t)b * 3072; const float* scl = shift + 1024;
        GAS unsigned long long* o8 = (GAS unsigned long long*)(H + (size_t)row * DM) + lane;
#pragma unroll
        for (int j = 0; j < 4; ++j) { const int c0 = 4 * lane + 256 * j;
            const f32x4 gg = *(const f32x4*)(g_norm + c0), sc = *(const f32x4*)(scl + c0), sh = *(const f32x4*)(shift + c0);
            const f32x4 o = v[j] * rstd * gg * (sc + 1.f) + sh;
            o8[64 * j] = (unsigned long long)pk2(o.x, o.y) | ((unsigned long long)pk2(o.z, o.w) << 32); }
    }
    GRID_BAR();
    {
        pg8::Gemm g{H, Win_t, M, INW, DM, DM, DM, 0}; pg8::StaticOrder S; S.init(M, INW, G, bx);
        pg8::EpiIn E{U, SZP, Q, Kb, Vb, SZA, SP, SA, tab};
        pg8::gemm_phase<pg8::EpiIn, pg8::StaticOrder, true, true>(L + RING_OFF, g, S, E);
    }
    GRID_BAR();
    for (long idx = gt; idx < BATCH * NH * NB * 64; idx += NGT) {
        const int d = (int)(idx & 63), j = (int)(idx >> 6) & 31, h = (int)(idx >> 11) & 7, b = (int)(idx >> 14);
        float s = 0.f; for (int t = 0; t < BLK; ++t) s += bf2f(Kb[(size_t)(b * SEQ + j * BLK + t) * 512 + h * 64 + d]);
        kmean[idx] = s * (1.f / BLK);
    }
    for (long idx = gt; idx < (long)M * 512; idx += NGT) {
        const int ch = (int)(idx & 511), m = (int)(idx >> 9), t = m % SEQ, g = ch >> 7, w = 2 << g, cnt = (t + 1 < w) ? t + 1 : w;
        float s = 0.f; for (int i = 0; i < cnt; ++i) s += bf2f(U[idx - (size_t)i * 512]);
        Dp[idx] = (bf16)f2bf(s / (float)cnt - bf2f(U[idx]));
    }
    GRID_BAR();
    for (long idx = gt; idx < (long)BATCH * NH * SEQ; idx += NGT) {
        const int t = (int)(idx % SEQ), h = (int)(idx / SEQ) % NH, b = (int)(idx / (SEQ * NH));
        const int m = b * SEQ + t, qblk = t / BLK;
        float q[64], o[64];
        { const v4u* qp = (const v4u*)(Q + (size_t)m * 512 + h * 64);
#pragma unroll
          for (int c = 0; c < 8; ++c) { const v4u r = qp[c];
#pragma unroll
              for (int e = 0; e < 4; ++e) { q[c * 8 + 2 * e] = __uint_as_float(r[e] << 16); q[c * 8 + 2 * e + 1] = __uint_as_float(r[e] & 0xffff0000u); } } }
#pragma unroll
        for (int d = 0; d < 64; ++d) o[d] = 0.f;
        float v1 = -INFINITY, v2 = -INFINITY, v3 = -INFINITY; int i1 = -1, i2 = -1, i3 = -1;
        const float* km = kmean + (size_t)(b * NH + h) * NB * 64;
        for (int j = 0; j < qblk; ++j) {
            float gsc = 0.f;
#pragma unroll
            for (int d = 0; d < 64; ++d) gsc += q[d] * km[j * 64 + d];
            if (gsc > v1) { v3 = v2; i3 = i2; v2 = v1; i2 = i1; v1 = gsc; i1 = j; }
            else if (gsc > v2) { v3 = v2; i3 = i2; v2 = gsc; i2 = j; }
            else if (gsc > v3) { v3 = gsc; i3 = j; }
        }
        float mx = -INFINITY, l = 0.f;
        for (int s = 0; s < 4; ++s) {
            const int blk = (s == 0) ? i1 : (s == 1) ? i2 : (s == 2) ? i3 : qblk; if (blk < 0) continue;
            const int nk = (s == 3) ? (t - qblk * BLK + 1) : BLK;
            const bf16* kp = Kb + (size_t)(b * SEQ + blk * BLK) * 512 + h * 64; const bf16* vp = Vb + (size_t)(b * SEQ + blk * BLK) * 512 + h * 64;
            for (int kk = 0; kk < nk; ++kk) {
                float sc = 0.f; const v4u* kr = (const v4u*)(kp + (size_t)kk * 512);
#pragma unroll
                for (int c = 0; c < 8; ++c) { const v4u r = kr[c];
#pragma unroll
                    for (int e = 0; e < 4; ++e) { sc += q[c * 8 + 2 * e] * __uint_as_float(r[e] << 16); sc += q[c * 8 + 2 * e + 1] * __uint_as_float(r[e] & 0xffff0000u); } }
                const float mn = fmaxf(mx, sc), f = exp2f(mx - mn), p = exp2f(sc - mn);
                l = l * f + p; mx = mn;
                const v4u* vr = (const v4u*)(vp + (size_t)kk * 512);
#pragma unroll
                for (int c = 0; c < 8; ++c) { const v4u r = vr[c];
#pragma unroll
                    for (int e = 0; e < 4; ++e) { o[c * 8 + 2 * e] = o[c * 8 + 2 * e] * f + p * __uint_as_float(r[e] << 16); o[c * 8 + 2 * e + 1] = o[c * 8 + 2 * e + 1] * f + p * __uint_as_float(r[e] & 0xffff0000u); } }
            }
        }
        const float il = 1.f / l; const size_t ob = (size_t)m * 512 + h * 64;
#pragma unroll
        for (int d = 0; d < 64; ++d) YA[ob + d] = (bf16)f2bf(o[d] * il * bf2f(SZA[ob + d]));
    }
    {
        pg8::Gemm g{Dp, Wg_t, M, 512, 256, 512, 256, 256}; pg8::StaticOrder S; S.init(M, 512, G, bx);
        pg8::EpiGate E{YP, SZP, nullptr, pscale, 512};
        pg8::gemm_phase<pg8::EpiGate, pg8::StaticOrder, true, true>(L + RING_OFF, g, S, E);
    }
    GRID_BAR();
    {
        pg8::Gemm g{YP, Wpu_t, M, DM, 512, 512, 512, 0}; pg8::StaticOrder S; S.init(M, DM, G, bx);
        pg8::EpiGate E{MG, SP, nullptr, nullptr, 1024};
        pg8::gemm_phase<pg8::EpiGate, pg8::StaticOrder, true, true>(L + RING_OFF, g, S, E);
    }
    GRID_BAR();
    {
        pg8::Gemm g{YA, Wau_t, M, DM, 512, 512, 512, 0}; pg8::StaticOrder S; S.init(M, DM, G, bx);
        pg8::EpiGate E{MG, SA, MG, nullptr, 1024};
        pg8::gemm_phase<pg8::EpiGate, pg8::StaticOrder, true, true>(L + RING_OFF, g, S, E);
    }
    GRID_BAR();
    {
        pg8::Gemm g{MG, Wout_t, M, DM, DM, DM, DM, 0}; pg8::StaticOrder S; S.init(M, DM, G, bx);
        pg8::EpiOut E{out, x, mod};
        pg8::gemm_phase<pg8::EpiOut, pg8::StaticOrder, true, true>(L + RING_OFF, g, S, E);
    }
    GRID_BAR();
    for (int row = gw; row < M; row += NGW) {
        GAS f32x4* xr = (GAS f32x4*)(out + (size_t)row * DM) + lane; f32x4 v[4]; float s = 0.f;
#pragma unroll
        for (int j = 0; j < 4; ++j) { v[j] = xr[64 * j]; s += (v[j].x * v[j].x + v[j].y * v[j].y) + (v[j].z * v[j].z + v[j].w * v[j].w); }
        const float rstd = rsqrtf(wave_sum(s) * (1.f / DM) + EPS);
#pragma unroll
        for (int j = 0; j < 4; ++j) { const f32x4 gg = *((const f32x4*)g_final + lane + 64 * j); xr[64 * j] = v[j] * rstd * gg; }
    }
}

extern "C" void kernel_launch(void* const* d_in, const int* in_sizes, int n_in, void* d_out, int out_size, void* d_ws, size_t ws_size, hipStream_t stream) {
    static int grid = 0;
    if (grid == 0) {
        if (n_in != 12 || in_sizes[0] != M * DM || out_size != M * DM || ws_size < WS_END) { fprintf(stderr, "kernel_launch: unexpected shapes (n_in %d, in0 %d, out %d, ws %zu)\n", n_in, n_in > 0 ? in_sizes[0] : -1, out_size, ws_size); grid = -1; return; }
        int dev = 0, cus = 0, per_cu = 0;
        if (hipGetDevice(&dev) != hipSuccess || hipDeviceGetAttribute(&cus, hipDeviceAttributeMultiprocessorCount, dev) != hipSuccess) { grid = -1; return; }
        if (hipFuncSetAttribute((const void*)mk_fwd, hipFuncAttributeMaxDynamicSharedMemorySize, LDS_BYTES) != hipSuccess) { fprintf(stderr, "kernel_launch: hipFuncSetAttribute failed\n"); grid = -1; return; }
        if (hipOccupancyMaxActiveBlocksPerMultiprocessor(&per_cu, (const void*)mk_fwd, NWAVES * 64, LDS_BYTES) != hipSuccess || per_cu < 1)
            fprintf(stderr, "kernel_launch: note: occupancy query reports %d workgroups per CU\n", per_cu);
        (void)hipGetLastError();
        grid = cus;
    }
    if (grid < 0) return;
    if (hipMemsetAsync((char*)d_ws + WS_CTL, 0, CTL_ZERO_BYTES, stream) != hipSuccess) { fprintf(stderr, "kernel_launch: memset failed\n"); return; }
    Args a{};
    for (int i = 0; i < 12; ++i) a.in[i] = (const float*)d_in[i];
    a.out = (float*)d_out; a.ws = (unsigned char*)d_ws;
    hipLaunchKernelGGL(mk_fwd, dim3(grid), dim3(NWAVES * 64), LDS_BYTES, stream, a);
    const hipError_t le = hipPeekAtLastError();
    if (le != hipSuccess) fprintf(stderr, "kernel_launch: launch failed: %s\n", hipGetErrorName(le));
}
```

```cpp
#include <hip/hip_runtime.h>
#include <cstdio>
#include <cstdint>
namespace pg8 {
#define PG8_LAS __attribute__((address_space(3)))
typedef unsigned short bf16_t;
typedef short bf16x8 __attribute__((ext_vector_type(8)));
typedef float f32x4 __attribute__((ext_vector_type(4)));
typedef unsigned u32x4 __attribute__((ext_vector_type(4)));
constexpr int BM = 256, BK = 64, HALF = 128, HTB = HALF * BK * 2  , STAGE_BYTES = 8 * HTB, NXCD = 8, WGM = 8;

__host__ __device__ __forceinline__ int lds_byte(int r, int c) { const int st = (r >> 4) * 2 + (c >> 5), rr = r & 15, cc = c & 31, ob = rr * 64 + cc * 2; return st * 1024 + (ob ^ (((ob >> 9) & 1) << 5)); }
__host__ __device__ __forceinline__ void stage_rc(int b, int& R, int& C) { const int st = b / 1024, sb = b % 1024, swz = sb ^ (((sb >> 9) & 1) << 5); R = (st >> 1) * 16 + swz / 64; C = (st & 1) * 32 + (swz % 64) / 2; }
__host__ __device__ __forceinline__ int perm32(int rho) { const int n = rho >> 4, i = rho & 15; return 8 * (i >> 2) + 4 * n + (i & 3); }

struct Unit { int pm, pn; };
struct Gemm { const bf16_t* A; const bf16_t* Bt; int M, N, K, lda, ldb, akoff; };

struct StaticOrder {
    int nM, nN, nwg, G, c;
    __host__ __device__ void init(int M, int N, int G_, int c_) { nM = M / BM; nN = N / BM; nwg = nM * nN; G = G_; c = c_; }
    __host__ __device__ bool next(int i, Unit& u) const {
        const long L = (long)i * G + c; if (L >= nwg) return false;
        int wgid = (int)L; { const int q = nwg / NXCD, r = nwg % NXCD, xcd = wgid % NXCD, off = wgid / NXCD; wgid = (xcd < r ? xcd * (q + 1) : r * (q + 1) + (xcd - r) * q) + off; }
        const int nig = WGM * nN, gid = wgid / nig, fm = gid * WGM, gsz = (nM - fm) < WGM ? (nM - fm) : WGM;
        u.pm = fm + ((wgid % nig) % gsz); u.pn = (wgid % nig) / gsz; return true;
    }
    __device__ __forceinline__ void a_ready(const Unit&) const {}
    __device__ __forceinline__ void done(const Unit&) const {}
};

constexpr int SEQ_ = 8192;
constexpr float C2_ = 0.125f * 1.4426950408889634f;
__device__ __forceinline__ unsigned cvt_pk_bf16(float lo, float hi) { unsigned r; asm volatile("v_cvt_pk_bf16_f32 %0, %1, %2" : "=v"(r) : "v"(lo), "v"(hi)); return r; }
__device__ __forceinline__ float bflo(unsigned w) { return __uint_as_float(w << 16); }
__device__ __forceinline__ float bfhi(unsigned w) { return __uint_as_float(w & 0xffff0000u); }
__device__ __forceinline__ float fsigm(float z) { return __builtin_amdgcn_rcpf(1.f + __expf(-z)); }
__device__ __forceinline__ float fsilu(float z) { return z * fsigm(z); }
__device__ __forceinline__ u32x4 pack8(const f32x4& v0, const f32x4& v1) { u32x4 w; w.x = cvt_pk_bf16(v0[0], v0[1]); w.y = cvt_pk_bf16(v0[2], v0[3]); w.z = cvt_pk_bf16(v1[0], v1[1]); w.w = cvt_pk_bf16(v1[2], v1[3]); return w; }

struct EpiIn {
    static constexpr bool PERM = true, AFTER_DRAIN = false;
    bf16_t *u, *szp, *q, *kf, *sza, *sp, *sa; const float* tab;
    __device__ __forceinline__ void operator()(const f32x4 (&acc)[2][2][4][2], const Unit& un, int wr, int wc, int fr, int fq) const {
        const int pn = un.pn; bf16_t* dst; int ld, ct, mode;
        if (pn < 2) { dst = u; ld = 512; ct = pn; mode = 0; }
        else if (pn < 4) { dst = szp; ld = 512; ct = pn - 2; mode = 1; }
        else if (pn < 6) { dst = q; ld = 512; ct = pn - 4; mode = 3; }
        else if (pn < 8) { dst = kf; ld = 512; ct = pn - 6; mode = 4; }
        else if (pn < 10) { dst = sza; ld = 512; ct = pn - 8; mode = 1; }
        else if (pn < 14) { dst = sp; ld = 1024; ct = pn - 10; mode = 2; }
        else { dst = sa; ld = 1024; ct = pn - 14; mode = 2; }
        const int row0 = un.pm * BM + wr * 64 + fr, col0 = ct * 256 + wc * 32 + 8 * fq;
        const bool rope = (mode >= 3) && ((wc & 1) == 0);
        const float sgn = (fq == 0) ? -1.f : 1.f; const bool rl = fq < 2;
#pragma unroll
        for (int ai = 0; ai < 2; ++ai)
#pragma unroll
            for (int m = 0; m < 4; ++m) {
                const int row = row0 + ai * HALF + m * 16;
                f32x4 cs0 = {1.f, 1.f, 1.f, 1.f}, cs1 = cs0, sn0 = {0.f, 0.f, 0.f, 0.f}, sn1 = sn0;
                if (rope) { const float* t = tab + (size_t)(row & (SEQ_ - 1)) * 16; cs0 = *(const f32x4*)t; cs1 = *(const f32x4*)(t + 4); sn0 = *(const f32x4*)(t + 8); sn1 = *(const f32x4*)(t + 12); }
#pragma unroll
                for (int bj = 0; bj < 2; ++bj) {
                    f32x4 v0 = acc[ai][bj][m][0], v1 = acc[ai][bj][m][1];
                    if (mode == 1) {
#pragma unroll
                        for (int e = 0; e < 4; ++e) { v0[e] = fsilu(v0[e]); v1[e] = fsilu(v1[e]); }
                    } else if (mode == 2) {
#pragma unroll
                        for (int e = 0; e < 4; ++e) { v0[e] = fsigm(v0[e]); v1[e] = fsigm(v1[e]); }
                    } else if (rope) {
#pragma unroll
                        for (int e = 0; e < 4; ++e) {
                            const float p0 = __shfl_xor(v0[e], 16), p1 = __shfl_xor(v1[e], 16);
                            const float r0 = v0[e] * cs0[e] + sgn * p0 * sn0[e], r1 = v1[e] * cs1[e] + sgn * p1 * sn1[e];
                            v0[e] = rl ? r0 : v0[e]; v1[e] = rl ? r1 : v1[e]; }
                    }
                    if (mode == 3) { v0 = v0 * C2_; v1 = v1 * C2_; }
                    if (mode == 4) {
                        const int head = 4 * ct + 2 * bj + (wc >> 1), s = 2 * (wc & 1) + (fq >> 1), hh = fq & 1, kt = 4 * ai + 2 * wr + (m >> 1), rr = (m & 1) * 16 + fr;
                        const size_t blk = ((size_t)(un.pm >> 5) * 8 + head) * 32 + (un.pm & 31);
                        *(u32x4*)(dst + blk * 16384 + (size_t)(kt * 4 + s) * 512 + (32 * hh + rr) * 8) = pack8(v0, v1);
                    } else {
                        *(u32x4*)(dst + (size_t)row * ld + col0 + bj * HALF) = pack8(v0, v1);
                    }
                }
            }
    }
};
struct EpiVT {
    static constexpr bool PERM = true, AFTER_DRAIN = false;
    bf16_t* vf;
    __device__ __forceinline__ void operator()(const f32x4 (&acc)[2][2][4][2], const Unit& un, int wr, int wc, int fr, int fq) const {
        typedef unsigned u32x2 __attribute__((ext_vector_type(2)));
        const int b = un.pn >> 5, j = un.pn & 31;
#pragma unroll
        for (int ai = 0; ai < 2; ++ai) {
            const int head = 4 * un.pm + 2 * ai + wr;
            bf16_t* base = vf + (((size_t)b * 8 + head) * 32 + j) * 16384;
#pragma unroll
            for (int m = 0; m < 4; ++m) {
                const int dt = m >> 1, dr = (m & 1) * 16 + fr;
#pragma unroll
                for (int bj = 0; bj < 2; ++bj) {
                    const int kt = 4 * bj + wc, sp_ = fq >> 1;
#pragma unroll
                    for (int n = 0; n < 2; ++n) {
                        const f32x4 v = acc[ai][bj][m][n];
                        u32x2 w; w.x = cvt_pk_bf16(v[0], v[1]); w.y = cvt_pk_bf16(v[2], v[3]);
                        *(u32x2*)(base + (size_t)((kt * 2 + dt) * 2 + sp_) * 512 + (32 * n + dr) * 8 + 4 * (fq & 1)) = w;
                    }
                }
            }
        }
    }
};
struct EpiGate {
    static constexpr bool PERM = true, AFTER_DRAIN = false;
    bf16_t* out; const bf16_t* mul; const bf16_t* add; const float* cs; int ld;
    __device__ __forceinline__ void operator()(const f32x4 (&acc)[2][2][4][2], const Unit& un, int wr, int wc, int fr, int fq) const {
        const int row0 = un.pm * BM + wr * 64 + fr, col0 = un.pn * BM + wc * 32 + 8 * fq;
        f32x4 c0[2], c1[2];
#pragma unroll
        for (int bj = 0; bj < 2; ++bj) { c0[bj] = cs ? *(const f32x4*)(cs + col0 + bj * HALF) : (f32x4){1.f, 1.f, 1.f, 1.f}; c1[bj] = cs ? *(const f32x4*)(cs + col0 + bj * HALF + 4) : (f32x4){1.f, 1.f, 1.f, 1.f}; }
#pragma unroll
        for (int ai = 0; ai < 2; ++ai)
#pragma unroll
            for (int m = 0; m < 4; ++m) {
                const size_t ro = (size_t)(row0 + ai * HALF + m * 16) * ld + col0;
#pragma unroll
                for (int bj = 0; bj < 2; ++bj) {
                    const u32x4 mw = *(const u32x4*)(mul + ro + bj * HALF);
                    f32x4 v0 = acc[ai][bj][m][0] * (f32x4){bflo(mw.x), bfhi(mw.x), bflo(mw.y), bfhi(mw.y)} * c0[bj];
                    f32x4 v1 = acc[ai][bj][m][1] * (f32x4){bflo(mw.z), bfhi(mw.z), bflo(mw.w), bfhi(mw.w)} * c1[bj];
                    if (add) { const u32x4 aw = *(const u32x4*)(add + ro + bj * HALF);
                        v0 = v0 + (f32x4){bflo(aw.x), bfhi(aw.x), bflo(aw.y), bfhi(aw.y)}; v1 = v1 + (f32x4){bflo(aw.z), bfhi(aw.z), bflo(aw.w), bfhi(aw.w)}; }
                    *(u32x4*)(out + ro + bj * HALF) = pack8(v0, v1);
                }
            }
    }
};
struct EpiOut {
    static constexpr bool PERM = false, AFTER_DRAIN = false;
    float* out; const float* x; const float* mod;
    __device__ __forceinline__ void operator()(const f32x4 (&acc)[2][2][4][2], const Unit& un, int wr, int wc, int fr, int fq) const {
        const int row0 = un.pm * BM + wr * 64 + fr, col0 = un.pn * BM + wc * 32 + 4 * fq;
        const float* gate = mod + (size_t)((un.pm * BM) / SEQ_) * 3072 + 2048;
        f32x4 gv[2][2];
#pragma unroll
        for (int bj = 0; bj < 2; ++bj)
#pragma unroll
            for (int n = 0; n < 2; ++n) gv[bj][n] = *(const f32x4*)(gate + col0 + bj * HALF + n * 16);
#pragma unroll
        for (int ai = 0; ai < 2; ++ai)
#pragma unroll
            for (int m = 0; m < 4; ++m) {
                const size_t ro = (size_t)(row0 + ai * HALF + m * 16) * 1024 + col0;
#pragma unroll
                for (int bj = 0; bj < 2; ++bj)
#pragma unroll
                    for (int n = 0; n < 2; ++n) *(f32x4*)(out + ro + bj * HALF + n * 16) = *(const f32x4*)(x + ro + bj * HALF + n * 16) + gv[bj][n] * acc[ai][bj][m][n];
            }
    }
};

template <class Epi, class Sched, bool ALIGN_EPI = false, bool SP2 = false>
__device__ __forceinline__ void gemm_phase(PG8_LAS unsigned char* lds, const Gemm g, const Sched& S, const Epi& E) {
    int tid_ = threadIdx.x; asm volatile("" : "+v"(tid_));
    const int tid = tid_, wid = __builtin_amdgcn_readfirstlane(tid >> 6), lane = tid & 63, wr = wid >> 2, wc = wid & 3, fr = lane & 15, fq = lane >> 4;
    const int K = g.K, nt = K / BK;
    unsigned voffA[2], voffB[2];
#pragma unroll
    for (int i = 0; i < 2; ++i) { int R, C; stage_rc(tid * 16 + i * 8192, R, C); const int Rb = Epi::PERM ? ((R & ~31) + perm32(R & 31)) : R;
        voffA[i] = (unsigned)(R * g.lda + C) * 2u; voffB[i] = (unsigned)(Rb * g.ldb + C) * 2u; }
    const size_t kstep = (size_t)(BK * 2);
    const size_t hstepA = (size_t)HALF * g.lda * 2, hstepB = (size_t)HALF * g.ldb * 2;
    const size_t tstepA = 2 * hstepA, tstepB = 2 * hstepB;
    const unsigned ldsw = (unsigned)wid * 1024u;
    const int aoff = lds_byte(wr * 64 + fr, fq * 8), boff = lds_byte(wc * 32 + fr, fq * 8);
#define PG8_SA(b, h) (((b) * 2 + (h)) * HTB)
#define PG8_SB(b, h) ((4 + (b) * 2 + (h)) * HTB)
#define PG8_STAGE(bufoff, gbase, voff) do { _Pragma("unroll") for (int _i = 0; _i < 2; ++_i) \
        __builtin_amdgcn_global_load_lds((const unsigned*)((const char*)(gbase) + (voff)[_i]), (PG8_LAS unsigned*)(lds + (bufoff) + ldsw + _i * 8192), 16, 0, 0); } while (0)
#define PG8_LDA(dst, b, h) do { _Pragma("unroll") for (int m = 0; m < 4; ++m) _Pragma("unroll") for (int k = 0; k < 2; ++k) dst[m][k] = *(const PG8_LAS bf16x8*)(lds + PG8_SA(b, h) + aoff + m * 2048 + k * 1024); } while (0)
#define PG8_LDB(dst, b, h) do { _Pragma("unroll") for (int n = 0; n < 2; ++n) _Pragma("unroll") for (int k = 0; k < 2; ++k) dst[n][k] = *(const PG8_LAS bf16x8*)(lds + PG8_SB(b, h) + boff + n * 2048 + k * 1024); } while (0)
#define PG8_MMA(ai, bj, At, Bt) do { __builtin_amdgcn_s_setprio(1); _Pragma("unroll") for (int m = 0; m < 4; ++m) _Pragma("unroll") for (int n = 0; n < 2; ++n) _Pragma("unroll") for (int k = 0; k < 2; ++k) \
        acc[ai][bj][m][n] = __builtin_amdgcn_mfma_f32_16x16x32_bf16(Bt[n][k], At[m][k], acc[ai][bj][m][n], 0, 0, 0); __builtin_amdgcn_s_setprio(0); } while (0)
#define PG8_WAIT_V(n) asm volatile("s_waitcnt vmcnt(" #n ")" ::: "memory")
#define PG8_WAIT_L(n) asm volatile("s_waitcnt lgkmcnt(" #n ")" ::: "memory")
#define PG8_BAR __builtin_amdgcn_s_barrier()
#define PG8_SCHED __builtin_amdgcn_sched_barrier(0)
    Unit cur, nxt; int ui = 0;
    if (!S.next(0, cur)) return;
    f32x4 acc[2][2][4][2];
#pragma unroll
    for (int a = 0; a < 2; ++a)
#pragma unroll
        for (int b = 0; b < 2; ++b)
#pragma unroll
            for (int m = 0; m < 4; ++m)
#pragma unroll
                for (int n = 0; n < 2; ++n) acc[a][b][m][n] = (f32x4){0.f, 0.f, 0.f, 0.f};
    bf16x8 At[4][2], B0[2][2], B1[2][2];
    const char* cA = (const char*)g.A + (size_t)cur.pm * tstepA + (size_t)cur.pn * g.akoff * 2; const char* cB = (const char*)g.Bt + (size_t)cur.pn * tstepB;
    S.a_ready(cur);
    if constexpr (SP2) {
        PG8_STAGE(PG8_SB(0, 0), cB, voffB); PG8_STAGE(PG8_SB(0, 1), cB + hstepB, voffB); PG8_STAGE(PG8_SA(0, 0), cA, voffA); PG8_STAGE(PG8_SA(0, 1), cA + hstepA, voffA);
        if (wr == 1) PG8_BAR;
        PG8_WAIT_V(2); PG8_BAR;
        PG8_STAGE(PG8_SB(1, 0), cB + kstep, voffB); PG8_STAGE(PG8_SA(1, 0), cA + kstep, voffA); PG8_STAGE(PG8_SB(1, 1), cB + hstepB + kstep, voffB);
        PG8_WAIT_V(6); PG8_BAR;
    } else {
        PG8_STAGE(PG8_SB(0, 0), cB, voffB); PG8_STAGE(PG8_SA(0, 0), cA, voffA); PG8_STAGE(PG8_SB(0, 1), cB + hstepB, voffB); PG8_STAGE(PG8_SA(0, 1), cA + hstepA, voffA);
        if (wr == 1) PG8_BAR;
        PG8_WAIT_V(4); PG8_BAR;
        PG8_STAGE(PG8_SB(1, 0), cB + kstep, voffB); PG8_STAGE(PG8_SA(1, 0), cA + kstep, voffA); PG8_STAGE(PG8_SB(1, 1), cB + hstepB + kstep, voffB);
        PG8_WAIT_V(6); PG8_BAR;
    }
    for (;;) {
        const bool has_next = S.next(ui + 1, nxt);
        const char* nA = has_next ? (const char*)g.A + (size_t)nxt.pm * tstepA + (size_t)nxt.pn * g.akoff * 2 : cA; const char* nB = has_next ? (const char*)g.Bt + (size_t)nxt.pn * tstepB : cB;
        for (int t = 0; t < nt; t += 2) {
            const bool last = (t == nt - 2);
            const char* a1 = cA + (size_t)(t + 1) * kstep;
            const char* a2 = last ? nA : cA + (size_t)(t + 2) * kstep; const char* b2 = last ? nB : cB + (size_t)(t + 2) * kstep;
            const char* a3 = a2 + kstep; const char* b3 = b2 + kstep;
            if (last && has_next) S.a_ready(nxt);
            if constexpr (SP2) {
            PG8_LDB(B0, 0, 0); PG8_LDB(B1, 0, 1); PG8_SCHED; PG8_LDA(At, 0, 0); PG8_STAGE(PG8_SA(1, 1), a1 + hstepA, voffA);
            PG8_WAIT_V(8); PG8_WAIT_L(0); PG8_BAR; PG8_MMA(0, 0, At, B0); PG8_MMA(0, 1, At, B1); PG8_BAR; PG8_SCHED;
            PG8_LDA(At, 0, 1); PG8_STAGE(PG8_SB(0, 0), b2, voffB); PG8_STAGE(PG8_SB(0, 1), b2 + hstepB, voffB); PG8_STAGE(PG8_SA(0, 0), a2, voffA);
            PG8_WAIT_V(8); PG8_WAIT_L(0); PG8_BAR; PG8_MMA(1, 0, At, B0); PG8_MMA(1, 1, At, B1); PG8_BAR; PG8_SCHED;
            PG8_LDB(B0, 1, 0); PG8_LDB(B1, 1, 1); PG8_SCHED; PG8_LDA(At, 1, 0); PG8_STAGE(PG8_SA(0, 1), a2 + hstepA, voffA);
            PG8_WAIT_V(8); PG8_WAIT_L(0); PG8_BAR; PG8_MMA(0, 0, At, B0); PG8_MMA(0, 1, At, B1); PG8_BAR; PG8_SCHED;
            PG8_LDA(At, 1, 1); PG8_STAGE(PG8_SB(1, 0), b3, voffB); PG8_STAGE(PG8_SB(1, 1), b3 + hstepB, voffB); PG8_STAGE(PG8_SA(1, 0), a3, voffA);
            PG8_WAIT_V(8); PG8_WAIT_L(0); PG8_BAR; PG8_MMA(1, 0, At, B0); PG8_MMA(1, 1, At, B1); PG8_BAR; PG8_SCHED;
            } else {
            PG8_LDB(B0, 0, 0); PG8_SCHED; PG8_LDA(At, 0, 0); PG8_STAGE(PG8_SA(1, 1), a1 + hstepA, voffA);
            PG8_WAIT_L(8); PG8_BAR; PG8_WAIT_L(0); PG8_MMA(0, 0, At, B0); PG8_BAR; PG8_SCHED;
            PG8_LDB(B1, 0, 1); PG8_STAGE(PG8_SB(0, 0), b2, voffB);
            PG8_BAR; PG8_WAIT_L(0); PG8_MMA(0, 1, At, B1); PG8_BAR;
            PG8_LDA(At, 0, 1); PG8_STAGE(PG8_SA(0, 0), a2, voffA);
            PG8_BAR; PG8_WAIT_L(0); PG8_MMA(1, 0, At, B0); PG8_BAR; PG8_SCHED;
            PG8_STAGE(PG8_SB(0, 1), b2 + hstepB, voffB);
            PG8_WAIT_V(6); PG8_BAR; PG8_MMA(1, 1, At, B1); PG8_BAR;
            PG8_LDB(B0, 1, 0); PG8_SCHED; PG8_LDA(At, 1, 0); PG8_STAGE(PG8_SA(0, 1), a2 + hstepA, voffA);
            PG8_WAIT_L(8); PG8_BAR; PG8_WAIT_L(0); PG8_MMA(0, 0, At, B0); PG8_BAR; PG8_SCHED;
            PG8_LDB(B1, 1, 1); PG8_STAGE(PG8_SB(1, 0), b3, voffB);
            PG8_BAR; PG8_WAIT_L(0); PG8_MMA(0, 1, At, B1); PG8_BAR;
            PG8_LDA(At, 1, 1); PG8_STAGE(PG8_SA(1, 0), a3, voffA);
            PG8_BAR; PG8_WAIT_L(0); PG8_MMA(1, 0, At, B0); PG8_BAR; PG8_SCHED;
            PG8_STAGE(PG8_SB(1, 1), b3 + hstepB, voffB);
            PG8_WAIT_V(6); PG8_BAR; PG8_MMA(1, 1, At, B1); PG8_BAR;
            }
        }
        if constexpr (ALIGN_EPI) { if (wr == 0) PG8_BAR; }
        if constexpr (!Epi::AFTER_DRAIN) { E(acc, cur, wr, wc, fr, fq); S.done(cur); }
        if (!has_next) break;
#pragma unroll
        for (int a = 0; a < 2; ++a)
#pragma unroll
            for (int b = 0; b < 2; ++b)
#pragma unroll
                for (int m = 0; m < 4; ++m)
#pragma unroll
                    for (int n = 0; n < 2; ++n) acc[a][b][m][n] = (f32x4){0.f, 0.f, 0.f, 0.f};
        cur = nxt; cA = nA; cB = nB; ++ui;
        if constexpr (ALIGN_EPI) { if (wr == 1) PG8_BAR; }
    }
    PG8_WAIT_V(0);
    if constexpr (!ALIGN_EPI) { if (wr == 0) PG8_BAR; }
    PG8_BAR;
    if constexpr (Epi::AFTER_DRAIN) { E.fused(acc, cur, wr, wc, fr, fq, lds, wid, lane); S.done(cur); }
#undef PG8_SA
#undef PG8_SB
#undef PG8_STAGE
#undef PG8_LDA
#undef PG8_LDB
#undef PG8_MMA
#undef PG8_WAIT_V
#undef PG8_WAIT_L
#undef PG8_BAR
#undef PG8_SCHED
}

}
#define GAS __attribute__((address_space(1)))
#define LAS __attribute__((address_space(3)))
typedef unsigned short bf16;
typedef unsigned v4u __attribute__((ext_vector_type(4)));
typedef float f32x4 __attribute__((ext_vector_type(4)));
typedef short bf16x8 __attribute__((ext_vector_type(8)));
typedef GAS unsigned gu32;
typedef GAS unsigned long long gu64;
#define RLX_AGENT __ATOMIC_RELAXED, __HIP_MEMORY_SCOPE_AGENT
#define LDS_WAIT() asm volatile("s_waitcnt lgkmcnt(0)" ::: "memory")
#define VM_WAIT() asm volatile("s_waitcnt vmcnt(0)" ::: "memory")
__device__ __forceinline__ unsigned long long rt() { return __builtin_amdgcn_s_memrealtime(); }
__device__ __forceinline__ unsigned f2bf(float f) { unsigned u = __builtin_bit_cast(unsigned, f); return (u + 0x7fffu + ((u >> 16) & 1u)) >> 16; }
__device__ __forceinline__ unsigned pk2(float lo, float hi) { return f2bf(lo) | (f2bf(hi) << 16); }

#define XB_TMO      128
#define XB_XCNT(j)  (256  + 64 * (j))
#define XB_XSUB(j)  (1280 + 64 * (j))
#define XB_XGEN(j)  (2304 + 64 * (j))
#define XB_TOP      3328
#define XB_TOPGEN   3392
#define XCD_BAR_WORDS 3456
#define XB_SPIN_CAP (1u << 18)

__device__ __forceinline__ unsigned xb_ld(unsigned* p)              { return __hip_atomic_load(p, __ATOMIC_RELAXED, __HIP_MEMORY_SCOPE_AGENT); }
__device__ __forceinline__ unsigned xb_add(unsigned* p, unsigned v) { return __hip_atomic_fetch_add(p, v, __ATOMIC_RELAXED, __HIP_MEMORY_SCOPE_AGENT); }
__device__ __forceinline__ unsigned xb_xcc_id() { return (unsigned)__builtin_amdgcn_s_getreg((3 << 11) | 20) & 0xFu; }
#define XB_SPIN(cond, bar) do { unsigned _sp = 0; while (cond) { __builtin_amdgcn_s_sleep(1); \
    if ((++_sp & 255u) == 0u) { if (xb_ld(&(bar)[XB_TMO])) break; if (_sp > XB_SPIN_CAP) { atomicAdd(&(bar)[XB_TMO], 1u); break; } } } } while (0)

struct XcdBarrier {
    unsigned* bar; unsigned x;
    volatile LAS unsigned* st;
};

__device__ __forceinline__ XcdBarrier xcd_barrier_post(unsigned* bar, volatile LAS unsigned* st) {
    XcdBarrier b; b.bar = bar; b.x = xb_xcc_id(); b.st = st;
    if (threadIdx.x == 0) (void)xb_add(&bar[XB_XCNT(b.x)], 1u);
    return b;
}
__device__ __forceinline__ void xcd_barrier_complete(unsigned* bar, unsigned x, unsigned& nloc, unsigned& nx) {
    const unsigned G = gridDim.x * gridDim.y * gridDim.z;
    unsigned sum, cnt, mine, sp = 0u;
    for (;;) {
        sum = 0u; cnt = 0u; mine = 0u;
#pragma unroll
        for (unsigned j = 0; j < 16; ++j) { const unsigned c = xb_ld(&bar[XB_XCNT(j)]); sum += c; cnt += (c > 0u) ? 1u : 0u; mine = (j == x) ? c : mine; }
        if (sum == G) break;
        __builtin_amdgcn_s_sleep(1);
        if ((++sp & 255u) == 0u) { if (xb_ld(&bar[XB_TMO])) break; if (sp > XB_SPIN_CAP) { atomicAdd(&bar[XB_TMO], 1u); break; } }
    }
    nloc = mine > 0u ? mine : 1u; nx = cnt > 0u ? cnt : 1u;
}

__device__ __forceinline__ void xcd_barrier(const XcdBarrier& b) {
    asm volatile("s_waitcnt vmcnt(0)" ::: "memory");
    __syncthreads();
    if (threadIdx.x == 0) {
        unsigned* bar = b.bar;
        __builtin_amdgcn_s_waitcnt(0);
        unsigned nloc = b.st[0], nx = b.st[1];
        if (nloc == 0u) { xcd_barrier_complete(bar, b.x, nloc, nx); b.st[0] = nloc; b.st[1] = nx; }
        const unsigned old = xb_add(&bar[XB_XSUB(b.x)], 1u);
        const unsigned gen = old / nloc;
        if (old + 1u == (gen + 1u) * nloc) {
            __builtin_amdgcn_fence(__ATOMIC_RELEASE, "agent");
            asm volatile("s_waitcnt vmcnt(0)" ::: "memory");
            const unsigned og = xb_add(&bar[XB_TOP], 1u);
            const unsigned tg = og / nx;
            if (og + 1u == (tg + 1u) * nx) xb_add(&bar[XB_TOPGEN], 1u);
            else XB_SPIN(xb_ld(&bar[XB_TOPGEN]) == tg, bar);
            __builtin_amdgcn_fence(__ATOMIC_ACQUIRE, "agent");
            xb_add(&bar[XB_XGEN(b.x)], 1u);
            asm volatile("s_waitcnt vmcnt(0)" ::: "memory");
        } else {
            XB_SPIN(xb_ld(&bar[XB_XGEN(b.x)]) == gen, bar);
            __builtin_amdgcn_fence(__ATOMIC_ACQUIRE, "agent");
            asm volatile("s_waitcnt vmcnt(0)" ::: "memory");
        }
    }
    __syncthreads();
}

constexpr int DM = 1024, BATCH = 4, SEQ = 8192, M = BATCH * SEQ, NH = 8, HD = 64, BLK = 256, NB = SEQ / BLK, INW = 5120;
constexpr float EPS = 1e-6f;
constexpr int NWAVES = 8;
constexpr size_t MiB = 1u << 20;
constexpr size_t WS_CTL = 0, CTL_ZERO_BYTES = 1 * MiB;
constexpr size_t WS_MOD = 1 * MiB, WS_KMEAN = 1 * MiB + 256 * 1024, WS_ROPE = 2 * MiB;
constexpr size_t WS_WIN = 4 * MiB, WS_WPU = 14 * MiB, WS_WAU = 15 * MiB, WS_WOUT = 16 * MiB, WS_WG = 18 * MiB;
constexpr size_t WS_H = 32 * MiB, WS_D = 32 * MiB, WS_YP = 64 * MiB;
constexpr size_t WS_U = 96 * MiB, WS_SZP = 128 * MiB, WS_Q = 160 * MiB, WS_YA = 160 * MiB, WS_K = 192 * MiB, WS_V = 224 * MiB, WS_MG = 192 * MiB;
constexpr size_t WS_SZA = 256 * MiB, WS_SP = 288 * MiB, WS_SA = 352 * MiB, WS_END = 416 * MiB;
constexpr int CW_BAR = 4096;
constexpr int RING_OFF = 0, RING_BYTES = 131072, LDSCTL_OFF = 155648, MISC_OFF = LDSCTL_OFF + 320, LDS_BYTES = 159744;

__device__ __forceinline__ float bf2f(bf16 v) { return __uint_as_float((unsigned)v << 16); }
__device__ __forceinline__ float wave_sum(float v) {
#pragma unroll
    for (int o = 1; o < 64; o <<= 1) v += __shfl_xor(v, o);
    return v;
}
__device__ __forceinline__ void p0_transpose_item(const float* W, int ldw, int K, int N, bf16* WT, int row_off, LAS float* scr, int item, int lane) {
    const int nblk = N / 32, kb = item / nblk, nb = item % nblk, k0 = 64 * kb, n0 = 32 * nb;
#pragma unroll 8
    for (int i = 0; i < 32; ++i) { const int kk = 2 * i + (lane >> 5); scr[kk * 33 + (lane & 31)] = W[(size_t)(k0 + kk) * ldw + n0 + (lane & 31)]; }
    LDS_WAIT(); asm volatile("" ::: "memory");
    const int c = lane & 7;
#pragma unroll
    for (int j = 0; j < 4; ++j) { const int n = (lane >> 3) + 8 * j; const LAS float* s = scr + (8 * c) * 33 + n;
        v4u o; o.x = pk2(s[0 * 33], s[1 * 33]); o.y = pk2(s[2 * 33], s[3 * 33]); o.z = pk2(s[4 * 33], s[5 * 33]); o.w = pk2(s[6 * 33], s[7 * 33]);
        *(GAS v4u*)(WT + (size_t)(row_off + n0 + n) * K + k0 + 8 * c) = o; }
    LDS_WAIT(); asm volatile("" ::: "memory");
}


typedef float f32x16 __attribute__((ext_vector_type(16)));
typedef unsigned u32x2 __attribute__((ext_vector_type(2)));
typedef float f32x2_t __attribute__((ext_vector_type(2))); typedef __bf16 bf16x2_t __attribute__((ext_vector_type(2)));
__device__ __forceinline__ unsigned cvtpk(float lo, float hi) { f32x2_t v = {lo, hi}; bf16x2_t b = __builtin_convertvector(v, bf16x2_t); return __builtin_bit_cast(unsigned, b); }
#define MFMA32(a, b, c) __builtin_amdgcn_mfma_f32_32x32x16_bf16(a, b, c, 0, 0, 0)
constexpr int AT_QS = 0, AT_SL = 32768, AT_ML = 131072, AT_LIST = 137216, AT_BITS = 153600, AT_CNT = 154624, AT_ITAB = 154752, AT_CTR = 155008, AT_END = 155024;
constexpr float NEG_BIG = -1e30f;

__device__ __forceinline__ float xhalf_max(float v) { auto rr = __builtin_amdgcn_permlane32_swap(__float_as_uint(v), __float_as_uint(v), false, false); return fmaxf(__uint_as_float(rr[0]), __uint_as_float(rr[1])); }
__device__ __forceinline__ float xhalf_sum(float v) { auto rr = __builtin_amdgcn_permlane32_swap(__float_as_uint(v), __float_as_uint(v), false, false); return __uint_as_float(rr[0]) + __uint_as_float(rr[1]); }
__device__ __forceinline__ bf16x8 pk8(const f32x16& p, int b0) {
    v4u w; w.x = cvtpk(p[b0], p[b0 + 1]); w.y = cvtpk(p[b0 + 2], p[b0 + 3]); w.z = cvtpk(p[b0 + 4], p[b0 + 5]); w.w = cvtpk(p[b0 + 6], p[b0 + 7]);
    return __builtin_bit_cast(bf16x8, w); }
__device__ __forceinline__ void ld_k(bf16x8 (&kf)[8], const unsigned char* Kfb, int c, int lane) {
#pragma unroll
    for (int i = 0; i < 8; ++i) kf[i] = *(const bf16x8*)(Kfb + (size_t)(c * 8 + i) * 1024 + lane * 16);
}
__device__ __forceinline__ void ld_v(bf16x8 (&vf)[8], const unsigned char* Vfb, int c, int lane) {
#pragma unroll
    for (int i = 0; i < 8; ++i) vf[i] = *(const bf16x8*)(Vfb + (size_t)(c * 8 + i) * 1024 + lane * 16);
}
__device__ __forceinline__ void qk_step(const bf16x8 (&kf)[8], const bf16x8 (&qf)[4], f32x16& p0, f32x16& p1) {
#pragma unroll
    for (int i = 0; i < 16; ++i) { p0[i] = 0.f; p1[i] = 0.f; }
#pragma unroll
    for (int s = 0; s < 4; ++s) { p0 = MFMA32(kf[s], qf[s], p0); p1 = MFMA32(kf[4 + s], qf[s], p1); }
}
__device__ __forceinline__ void sm_step(f32x16& p0, f32x16& p1, bf16x8 (&pf)[4], f32x16& o0, f32x16& o1, float& m, float& l, int mm0, int mm1, int r, int hh) {
    if (mm0) {
#pragma unroll
        for (int i = 0; i < 16; ++i) { const int key = (i & 3) + 8 * (i >> 2) + 4 * hh; if (mm0 == 2 || key > r) p0[i] = NEG_BIG; } }
    if (mm1) {
#pragma unroll
        for (int i = 0; i < 16; ++i) { const int key = (i & 3) + 8 * (i >> 2) + 4 * hh; if (mm1 == 2 || key > r) p1[i] = NEG_BIG; } }
    float mx = fmaxf(p0[0], p1[0]);
#pragma unroll
    for (int i = 1; i < 16; ++i) mx = fmaxf(mx, fmaxf(p0[i], p1[i]));
    mx = xhalf_max(mx);
    const float mn = fmaxf(m, mx), f = __builtin_amdgcn_exp2f(m - mn); m = mn;
    float rs = 0.f;
#pragma unroll
    for (int i = 0; i < 16; ++i) { p0[i] = __builtin_amdgcn_exp2f(p0[i] - mn); p1[i] = __builtin_amdgcn_exp2f(p1[i] - mn); rs += p0[i] + p1[i]; }
    l = l * f + rs;
#pragma unroll
    for (int i = 0; i < 16; ++i) { o0[i] *= f; o1[i] *= f; }
    pf[0] = pk8(p0, 0); pf[1] = pk8(p0, 8); pf[2] = pk8(p1, 0); pf[3] = pk8(p1, 8);
}
__device__ __forceinline__ void pv_step(const bf16x8 (&vf)[8], const bf16x8 (&pf)[4], f32x16& o0, f32x16& o1) {
    o0 = MFMA32(vf[0], pf[0], o0); o0 = MFMA32(vf[1], pf[1], o0); o1 = MFMA32(vf[2], pf[0], o1); o1 = MFMA32(vf[3], pf[1], o1);
    o0 = MFMA32(vf[4], pf[2], o0); o0 = MFMA32(vf[5], pf[3], o0); o1 = MFMA32(vf[6], pf[2], o1); o1 = MFMA32(vf[7], pf[3], o1);
}
__device__ __forceinline__ void ld_q(bf16x8 (&qf)[4], const LAS unsigned char* L, int qi, int hh) {
#pragma unroll
    for (int s = 0; s < 4; ++s) qf[s] = *(const LAS bf16x8*)(L + AT_QS + qi * 128 + (((2 * s + hh) ^ ((qi >> 1) & 7)) * 16));
}

__device__ __forceinline__ void attn_unit(LAS unsigned char* L, unsigned char* lds_g, int b, int h, int iblk, const bf16* Q, const unsigned char* Kf, const unsigned char* Vf, const float* kmean,
                                          const bf16* SZA, bf16* YA, int wave) {
    int tid_ = threadIdx.x; asm volatile("" : "+v"(tid_));
    const int tid = tid_, lane = tid & 63, r = lane & 31, hh = lane >> 5;
    const size_t row0 = (size_t)b * SEQ + (size_t)iblk * BLK;
    const unsigned char* Kbh = Kf + (size_t)(b * 8 + h) * 32 * 32768; const unsigned char* Vbh = Vf + (size_t)(b * 8 + h) * 32 * 32768;
#pragma unroll
    for (int i = 0; i < 4; ++i) { const int e = tid + 512 * i, row = e >> 3, ch = e & 7;
        const v4u v = *(const v4u*)(Q + (row0 + row) * 512 + h * 64 + ch * 8);
        *(LAS v4u*)(L + AT_QS + row * 128 + ((ch ^ ((row >> 1) & 7)) * 16)) = v; }
    if (tid == 0) { *(LAS unsigned*)(L + AT_CTR) = 0u; *(LAS unsigned*)(L + AT_CTR + 4) = 0u; }
    __syncthreads();
    const int nsel = iblk < 3 ? iblk : 3;
    if (iblk > 0) {
        const int t = tid & 255, par = wave >> 2;
        float v1 = -INFINITY, v2 = -INFINITY, v3 = -INFINITY; int i1 = -1, i2 = -1, i3 = -1;
        {
            float qv[64];
#pragma unroll
            for (int c = 0; c < 8; ++c) { const v4u w = *(const LAS v4u*)(L + AT_QS + t * 128 + ((c ^ ((t >> 1) & 7)) * 16));
#pragma unroll
                for (int e = 0; e < 4; ++e) { qv[c * 8 + 2 * e] = __uint_as_float(w[e] << 16); qv[c * 8 + 2 * e + 1] = __uint_as_float(w[e] & 0xffff0000u); } }
            const float* km = kmean + (size_t)(b * 8 + h) * 32 * 64;
            for (int j = par; j < iblk; j += 2) {
                float g0 = 0.f, g1 = 0.f;
#pragma unroll
                for (int d = 0; d < 64; d += 2) { g0 += qv[d] * km[j * 64 + d]; g1 += qv[d + 1] * km[j * 64 + d + 1]; }
                const float g = g0 + g1;
                if (g > v1) { v3 = v2; i3 = i2; v2 = v1; i2 = i1; v1 = g; i1 = j; }
                else if (g > v2) { v3 = v2; i3 = i2; v2 = g; i2 = j; }
                else if (g > v3) { v3 = g; i3 = j; }
            }
        }
        LAS float* cand = (LAS float*)(L + AT_SL);
        if (par == 1) { cand[(t * 3 + 0) * 2] = v1; cand[(t * 3 + 0) * 2 + 1] = __int_as_float(i1); cand[(t * 3 + 1) * 2] = v2; cand[(t * 3 + 1) * 2 + 1] = __int_as_float(i2);
                        cand[(t * 3 + 2) * 2] = v3; cand[(t * 3 + 2) * 2 + 1] = __int_as_float(i3); }
        __syncthreads();
        if (par == 0) {
#pragma unroll
            for (int k = 0; k < 3; ++k) { const float g = cand[(t * 3 + k) * 2]; const int j = __float_as_int(cand[(t * 3 + k) * 2 + 1]);
                if (j >= 0) {
                    if (g > v1 || (g == v1 && j < i1)) { v3 = v2; i3 = i2; v2 = v1; i2 = i1; v1 = g; i1 = j; }
                    else if (g > v2 || (g == v2 && j < i2)) { v3 = v2; i3 = i2; v2 = g; i2 = j; }
                    else if (g > v3 || (g == v3 && j < i3)) { v3 = g; i3 = j; } } }
            LAS unsigned long long* bits = (LAS unsigned long long*)(L + AT_BITS);
            for (int j = 0; j < iblk; ++j) { const unsigned long long bm = __ballot(i1 == j || i2 == j || i3 == j); if (lane == 0) bits[j * 4 + wave] = bm; }
        }
        __syncthreads();
        if (par == 0) {
            const LAS unsigned long long* bits = (const LAS unsigned long long*)(L + AT_BITS);
            LAS unsigned short* list = (LAS unsigned short*)(L + AT_LIST);
            const unsigned long long below = (1ull << lane) - 1ull;
#pragma unroll
            for (int k = 0; k < 3; ++k) { const int j = (k == 0) ? i1 : (k == 1) ? i2 : i3;
                if (j >= 0) { int pos = 0;
                    for (int w = 0; w < 4; ++w) { const unsigned long long bm = bits[j * 4 + w]; pos += (w < wave) ? __popcll(bm) : (w == wave ? __popcll(bm & below) : 0); }
                    list[j * 256 + pos] = (unsigned short)(t | (k << 8)); } }
            if (tid < 64) {
                int c = 0; if (lane < iblk) c = __popcll(bits[lane * 4]) + __popcll(bits[lane * 4 + 1]) + __popcll(bits[lane * 4 + 2]) + __popcll(bits[lane * 4 + 3]);
                const int ng = (c + 31) >> 5; int inc = ng;
#pragma unroll
                for (int o = 1; o < 32; o <<= 1) { const int u = __shfl_up(inc, o); if (lane >= o) inc += u; }
                const int base = inc - ng;
                if (lane < 32) ((LAS int*)(L + AT_CNT))[lane] = c;
                for (int g = 0; g < ng; ++g) ((LAS int*)(L + AT_ITAB))[base + g] = (lane << 8) | g;
                if (lane == 31) *(LAS int*)(L + AT_CTR + 4) = inc;
            }
        }
        __syncthreads();
        const int T = *(const LAS int*)(L + AT_CTR + 4);
        for (int it = wave; it < T; it += 8) {
            const int e = __builtin_amdgcn_readfirstlane(((const LAS int*)(L + AT_ITAB))[it]), j = e >> 8, g = e & 255, cj = __builtin_amdgcn_readfirstlane(((const LAS int*)(L + AT_CNT))[j]);
            const bool active = (32 * g + r) < cj;
            const unsigned ent = ((const LAS unsigned short*)(L + AT_LIST))[j * 256 + (active ? 32 * g + r : 32 * g)];
            const int qi = ent & 255, slot = ent >> 8;
            bf16x8 qf[4]; ld_q(qf, L, qi, hh);
            const unsigned char* Kfb = Kbh + (size_t)j * 32768; const unsigned char* Vfb = Vbh + (size_t)j * 32768;
            f32x16 o0, o1, p0, p1;
#pragma unroll
            for (int i = 0; i < 16; ++i) { o0[i] = 0.f; o1[i] = 0.f; }
            float m = NEG_BIG, l = 0.f;
            bf16x8 kf[8], vf[8], pf[4];
            ld_k(kf, Kfb, 0, lane); ld_v(vf, Vfb, 0, lane);
#pragma unroll
            for (int c = 0; c < 4; ++c) {
                qk_step(kf, qf, p0, p1);
                if (c < 3) ld_k(kf, Kfb, c + 1, lane);
                sm_step(p0, p1, pf, o0, o1, m, l, 0, 0, r, hh);
                pv_step(vf, pf, o0, o1);
                if (c < 3) ld_v(vf, Vfb, c + 1, lane);
            }
            l = xhalf_sum(l);
            if (active) {
                const float inv = __builtin_amdgcn_rcpf(l); const int row = qi * 3 + slot;
#pragma unroll
                for (int dt = 0; dt < 2; ++dt)
#pragma unroll
                    for (int rg = 0; rg < 4; ++rg) { const f32x16& o = dt ? o1 : o0;
                        u32x2 w; w.x = cvtpk(o[4 * rg] * inv, o[4 * rg + 1] * inv); w.y = cvtpk(o[4 * rg + 2] * inv, o[4 * rg + 3] * inv);
                        *(LAS u32x2*)(L + AT_SL + row * 128 + (((8 * dt + 2 * rg + hh) ^ (row & 15)) * 8)) = w; }
                if (hh == 0) { LAS float* ml = (LAS float*)(L + AT_ML + row * 8); ml[0] = m; ml[1] = l; }
            }
        }
    }
    __syncthreads();
    {
        const int qi = 32 * wave + r;
        bf16x8 qf[4]; ld_q(qf, L, qi, hh);
        const unsigned char* Kfb = Kbh + (size_t)iblk * 32768; const unsigned char* Vfb = Vbh + (size_t)iblk * 32768;
        f32x16 o0, o1, p0, p1;
#pragma unroll
        for (int i = 0; i < 16; ++i) { o0[i] = 0.f; o1[i] = 0.f; }
        float m = NEG_BIG, l = 0.f;
        bf16x8 kf[8], vf[8], pf[4];
        const int nch = (wave >> 1) + 1;
        ld_k(kf, Kfb, 0, lane); ld_v(vf, Vfb, 0, lane);
#pragma unroll
        for (int c = 0; c < 4; ++c) {
            if (c < nch) {
                qk_step(kf, qf, p0, p1);
                if (c + 1 < nch) ld_k(kf, Kfb, c + 1, lane);
                const int mm0 = (2 * c > wave) ? 2 : (2 * c == wave ? 1 : 0), mm1 = (2 * c + 1 > wave) ? 2 : (2 * c + 1 == wave ? 1 : 0);
                sm_step(p0, p1, pf, o0, o1, m, l, mm0, mm1, r, hh);
                pv_step(vf, pf, o0, o1);
                if (c + 1 < nch) ld_v(vf, Vfb, c + 1, lane);
            }
        }
        l = xhalf_sum(l);
        float Mx = m;
        float ms[3], ls[3];
#pragma unroll
        for (int s = 0; s < 3; ++s) { ms[s] = NEG_BIG; ls[s] = 0.f;
            if (s < nsel) { const LAS float* ml = (const LAS float*)(L + AT_ML + (qi * 3 + s) * 8); ms[s] = ml[0]; ls[s] = ml[1]; Mx = fmaxf(Mx, ms[s]); } }
        const float wo = __builtin_amdgcn_exp2f(m - Mx); float Lt = l * wo;
#pragma unroll
        for (int i = 0; i < 16; ++i) { o0[i] *= wo; o1[i] *= wo; }
#pragma unroll
        for (int s = 0; s < 3; ++s) {
            if (s < nsel) {
                const float wsl = ls[s] * __builtin_amdgcn_exp2f(ms[s] - Mx); Lt += wsl; const int row = qi * 3 + s;
#pragma unroll
                for (int dt = 0; dt < 2; ++dt)
#pragma unroll
                    for (int rg = 0; rg < 4; ++rg) { const u32x2 w = *(const LAS u32x2*)(L + AT_SL + row * 128 + (((8 * dt + 2 * rg + hh) ^ (row & 15)) * 8));
                        f32x16& o = dt ? o1 : o0;
                        o[4 * rg] += wsl * pg8::bflo(w.x); o[4 * rg + 1] += wsl * pg8::bfhi(w.x); o[4 * rg + 2] += wsl * pg8::bflo(w.y); o[4 * rg + 3] += wsl * pg8::bfhi(w.y); }
            }
        }
        const float inv = __builtin_amdgcn_rcpf(Lt);
        const size_t gro = (row0 + qi) * 512 + h * 64;
#pragma unroll
        for (int dt = 0; dt < 2; ++dt)
#pragma unroll
            for (int rg = 0; rg < 4; ++rg) { const int d0 = 32 * dt + 8 * rg + 4 * hh; const f32x16& o = dt ? o1 : o0;
                const u32x2 gz = *(const u32x2*)(SZA + gro + d0);
                u32x2 w; w.x = cvtpk(o[4 * rg] * inv * pg8::bflo(gz.x), o[4 * rg + 1] * inv * pg8::bfhi(gz.x));
                w.y = cvtpk(o[4 * rg + 2] * inv * pg8::bflo(gz.y), o[4 * rg + 3] * inv * pg8::bfhi(gz.y));
                *(u32x2*)(YA + gro + d0) = w; }
    }
    __syncthreads();
}

struct Args { const float* in[12]; float* out; unsigned char* ws; };
__device__ __forceinline__ int fresh_tid() { int t = threadIdx.x; asm volatile("" : "+v"(t)); return t; }

__global__ void __launch_bounds__(NWAVES * 64, 2) mk_fwd(Args args) {
    extern __shared__ __attribute__((aligned(16))) unsigned char lds[];
    LAS unsigned char* L = (LAS unsigned char*)lds;
    volatile LAS unsigned* MISC = (volatile LAS unsigned*)(L + MISC_OFF);
    const int wave = __builtin_amdgcn_readfirstlane((int)threadIdx.x >> 6);
    const int G = gridDim.x, bx = blockIdx.x;
    const int vcu = (G % 8 == 0) ? (bx % 8) * (G / 8) + bx / 8 : bx;
    const int gw = vcu * NWAVES + wave, NGW = G * NWAVES;
    const long NGT = (long)G * NWAVES * 64;
#define PHASE_IDS() const int tid = fresh_tid(), lane = tid & 63; const long gt = (long)vcu * (NWAVES * 64) + tid; (void)lane; (void)gt
    unsigned char* ws = args.ws;
    const float *x = args.in[0], *cvec = args.in[1], *w_ada = args.in[2], *b_ada = args.in[3], *g_norm = args.in[4], *w_in = args.in[5], *w_grp = args.in[6], *pscale = args.in[7],
                *w_pu = args.in[8], *w_au = args.in[9], *w_out = args.in[10], *g_final = args.in[11];
    float* out = args.out;
    unsigned* ctl = (unsigned*)(ws + WS_CTL);
    float* mod = (float*)(ws + WS_MOD); float* kmean = (float*)(ws + WS_KMEAN); float* tab = (float*)(ws + WS_ROPE);
    bf16 *Win_t = (bf16*)(ws + WS_WIN), *Wpu_t = (bf16*)(ws + WS_WPU), *Wau_t = (bf16*)(ws + WS_WAU), *Wout_t = (bf16*)(ws + WS_WOUT), *Wg_t = (bf16*)(ws + WS_WG);
    bf16 *H = (bf16*)(ws + WS_H), *Dp = (bf16*)(ws + WS_D), *YP = (bf16*)(ws + WS_YP), *U = (bf16*)(ws + WS_U), *SZP = (bf16*)(ws + WS_SZP), *Q = (bf16*)(ws + WS_Q), *YA = (bf16*)(ws + WS_YA),
         *Kb = (bf16*)(ws + WS_K), *Vb = (bf16*)(ws + WS_V), *MG = (bf16*)(ws + WS_MG), *SZA = (bf16*)(ws + WS_SZA), *SP = (bf16*)(ws + WS_SP), *SA = (bf16*)(ws + WS_SA);

    for (int u = threadIdx.x; u < (LDS_BYTES - LDSCTL_OFF) / 4; u += NWAVES * 64) ((LAS unsigned*)(L + LDSCTL_OFF))[u] = 0u;
    __syncthreads();
    XcdBarrier bar = xcd_barrier_post(ctl + CW_BAR, MISC + 8);
#define GRID_BAR() xcd_barrier(bar)

    {
        PHASE_IDS();
        LAS float* red = (LAS float*)(L + RING_OFF);
        for (int it = bx; it < 192; it += G) {
            const int n0 = it * 16, ni = tid & 15, ks = tid >> 4;
            float a0 = 0.f, a1 = 0.f, a2 = 0.f, a3 = 0.f;
#pragma unroll 8
            for (int j = 0; j < 32; ++j) { const int k = ks + 32 * j; const float w = w_ada[(size_t)k * 3072 + n0 + ni];
                a0 += cvec[k] * w; a1 += cvec[1024 + k] * w; a2 += cvec[2048 + k] * w; a3 += cvec[3072 + k] * w; }
            red[(0 * 32 + ks) * 16 + ni] = a0; red[(1 * 32 + ks) * 16 + ni] = a1; red[(2 * 32 + ks) * 16 + ni] = a2; red[(3 * 32 + ks) * 16 + ni] = a3;
            __syncthreads();
            if (tid < 64) { const int b = tid >> 4; float s = b_ada[n0 + ni];
                for (int q = 0; q < 32; ++q) s += red[(b * 32 + q) * 16 + ni];
                mod[b * 3072 + n0 + ni] = s; }
            __syncthreads();
        }
        for (long idx = gt; idx < SEQ * 8; idx += NGT) {
            const int pos = (int)(idx >> 3), i = (int)(idx & 7);
            const float invf[8] = {1.0f, 0.1939227432012558f, 0.03760603070259094f, 0.007292664609849453f, 0.0014142135623842478f, 0.00027424818836152554f, 5.318296098266728e-05f, 1.0313386155758053e-05f};
            float inv = invf[0];
#pragma unroll
            for (int q = 1; q < 8; ++q) inv = (i == q) ? invf[q] : inv;
            const float angf = (float)pos * inv;
            const double ang = (double)angf, kq = rint(ang * 0.15915494309189535);
            double r = fma(-kq, 6.283185307179586, ang); r = fma(-kq, 2.4492935982947064e-16, r);
            const float rf = (float)r;
            tab[pos * 16 + i] = cosf(rf); tab[pos * 16 + 8 + i] = sinf(rf);
        }
        LAS float* scr = (LAS float*)(L + RING_OFF + wave * 16384);
        constexpr int I_A = (DM / 64) * (2048 / 32), I_V = (DM / 64) * (512 / 32), I_C = (DM / 64) * (2560 / 32), I_PU = (512 / 64) * (DM / 32), I_OUT = (DM / 64) * (DM / 32);
        constexpr int NITEMS = I_A + I_V + I_C + 2 * I_PU + I_OUT;
        for (int it = gw; it < NITEMS; it += NGW) {
            int r = it;
            if (r < I_A) { p0_transpose_item(w_in, INW, DM, 2048, Win_t, 0, scr, r, lane); continue; } r -= I_A;
            if (r < I_V) { p0_transpose_item(w_in + 2048, INW, DM, 512, Win_t, 4608, scr, r, lane); continue; } r -= I_V;
            if (r < I_C) { p0_transpose_item(w_in + 2560, INW, DM, 2560, Win_t, 2048, scr, r, lane); continue; } r -= I_C;
            if (r < I_PU) { p0_transpose_item(w_pu, DM, 512, DM, Wpu_t, 0, scr, r, lane); continue; } r -= I_PU;
            if (r < I_PU) { p0_transpose_item(w_au, DM, 512, DM, Wau_t, 0, scr, r, lane); continue; } r -= I_PU;
            p0_transpose_item(w_out, DM, DM, DM, Wout_t, 0, scr, r, lane);
        }
        for (long idx = gt; idx < 512 * 256; idx += NGT) {
            const int n = (int)(idx >> 8), kl = (int)(idx & 255), g = n >> 7, kg = (n >> 8) * 2 + (kl >> 7);
            const float v = (kg == g) ? w_grp[((size_t)g * 128 + (kl & 127)) * 128 + (n & 127)] : 0.f;
            Wg_t[idx] = (bf16)f2bf(v);
        }
    }
    GRID_BAR();
    { PHASE_IDS();
    for (int row = gw; row < M; row += NGW) {
        const int b = row / SEQ;
        const GAS f32x4* xr = (const GAS f32x4*)(x + (size_t)row * DM) + lane;
        f32x4 v[4]; float s = 0.f;
#pragma unroll
        for (int j = 0; j < 4; ++j) { v[j] = xr[64 * j]; s += (v[j].x * v[j].x + v[j].y * v[j].y) + (v[j].z * v[j].z + v[j].w * v[j].w); }
        const float rstd = rsqrtf(wave_sum(s) * (1.f / DM) + EPS);
        const float* shift = mod + (size_t)b * 3072; const float* scl = shift + 1024;
        GAS unsigned long long* o8 = (GAS unsigned long long*)(H + (size_t)row * DM) + lane;
#pragma unroll
        for (int j = 0; j < 4; ++j) { const int c0 = 4 * lane + 256 * j;
            const f32x4 gg = *(const f32x4*)(g_norm + c0), sc = *(const f32x4*)(scl + c0), sh = *(const f32x4*)(shift + c0);
            const f32x4 o = v[j] * rstd * gg * (sc + 1.f) + sh;
            o8[64 * j] = (unsigned long long)pk2(o.x, o.y) | ((unsigned long long)pk2(o.z, o.w) << 32); }
    } }
    GRID_BAR();
    {
        pg8::Gemm g{H, Win_t, M, 4608, DM, DM, DM, 0}; pg8::StaticOrder S; S.init(M, 4608, G, bx);
        pg8::EpiIn E{U, SZP, Q, Kb, SZA, SP, SA, tab};
        pg8::gemm_phase<pg8::EpiIn, pg8::StaticOrder, true, true>(L + RING_OFF, g, S, E);
    }
    {
        pg8::Gemm g{Win_t + (size_t)4608 * DM, H, 512, M, DM, DM, DM, 0}; pg8::StaticOrder S; S.init(512, M, G, bx);
        pg8::EpiVT E{Vb};
        pg8::gemm_phase<pg8::EpiVT, pg8::StaticOrder, true, true>(L + RING_OFF, g, S, E);
    }
    GRID_BAR();
    { PHASE_IDS();
    for (int it = gw; it < BATCH * NH * NB; it += NGW) {
        const unsigned char* kb_ = ws + WS_K + (size_t)it * 32768;
        float a[4][8];
#pragma unroll
        for (int s = 0; s < 4; ++s)
#pragma unroll
            for (int e = 0; e < 8; ++e) a[s][e] = 0.f;
#pragma unroll
        for (int kt = 0; kt < 8; ++kt)
#pragma unroll
            for (int s = 0; s < 4; ++s) { const v4u w = *(const v4u*)(kb_ + (kt * 4 + s) * 1024 + lane * 16);
#pragma unroll
                for (int e = 0; e < 4; ++e) { a[s][2 * e] += __uint_as_float(w[e] << 16); a[s][2 * e + 1] += __uint_as_float(w[e] & 0xffff0000u); } }
#pragma unroll
        for (int s = 0; s < 4; ++s)
#pragma unroll
            for (int e = 0; e < 8; ++e) { float v = a[s][e];
#pragma unroll
                for (int o = 1; o < 32; o <<= 1) v += __shfl_xor(v, o);
                a[s][e] = v; }
        if ((lane & 31) == 0) {
#pragma unroll
            for (int s = 0; s < 4; ++s)
#pragma unroll
                for (int e = 0; e < 8; ++e) kmean[(size_t)it * 64 + 16 * s + 8 * (lane >> 5) + e] = a[s][e] * (1.f / 256.f); }
    }
    for (long idx = gt; idx < (long)M * 512; idx += NGT) {
        const int ch = (int)(idx & 511), m = (int)(idx >> 9), t = m % SEQ, g = ch >> 7, w = 2 << g, cnt = (t + 1 < w) ? t + 1 : w;
        float s = 0.f; for (int i = 0; i < cnt; ++i) s += bf2f(U[idx - (size_t)i * 512]);
        Dp[idx] = (bf16)f2bf(s / (float)cnt - bf2f(U[idx]));
    } }
    GRID_BAR();
    {
    for (int u = 0;; ++u) {
        const int n = u * G + vcu; if (n >= BATCH * NH * NB) break;
        int pair, iblk;
        if (G == 256) { pair = vcu >> 3; const int s = vcu & 7; iblk = (u == 0) ? 31 - s : (u == 1) ? 16 + s : (u == 2) ? 15 - s : s; }
        else { pair = n >> 5; iblk = n & 31; }
        attn_unit(L, lds, pair >> 3, pair & 7, iblk, Q, ws + WS_K, ws + WS_V, kmean, SZA, YA, wave);
    } }
    {
        pg8::Gemm g{Dp, Wg_t, M, 512, 256, 512, 256, 256}; pg8::StaticOrder S; S.init(M, 512, G, bx);
        pg8::EpiGate E{YP, SZP, nullptr, pscale, 512};
        pg8::gemm_phase<pg8::EpiGate, pg8::StaticOrder, true, true>(L + RING_OFF, g, S, E);
    }
    GRID_BAR();
    {
        pg8::Gemm g{YP, Wpu_t, M, DM, 512, 512, 512, 0}; pg8::StaticOrder S; S.init(M, DM, G, bx);
        pg8::EpiGate E{MG, SP, nullptr, nullptr, 1024};
        pg8::gemm_phase<pg8::EpiGate, pg8::StaticOrder, true, true>(L + RING_OFF, g, S, E);
    }
    GRID_BAR();
    {
        pg8::Gemm g{YA, Wau_t, M, DM, 512, 512, 512, 0}; pg8::StaticOrder S; S.init(M, DM, G, bx);
        pg8::EpiGate E{MG, SA, MG, nullptr, 1024};
        pg8::gemm_phase<pg8::EpiGate, pg8::StaticOrder, true, true>(L + RING_OFF, g, S, E);
    }
    GRID_BAR();
    {
        pg8::Gemm g{MG, Wout_t, M, DM, DM, DM, DM, 0}; pg8::StaticOrder S; S.init(M, DM, G, bx);
        pg8::EpiOut E{out, x, mod};
        pg8::gemm_phase<pg8::EpiOut, pg8::StaticOrder, true, true>(L + RING_OFF, g, S, E);
    }
    GRID_BAR();
    { PHASE_IDS();
    for (int row = gw; row < M; row += NGW) {
        GAS f32x4* xr = (GAS f32x4*)(out + (size_t)row * DM) + lane; f32x4 v[4]; float s = 0.f;
#pragma unroll
        for (int j = 0; j < 4; ++j) { v[j] = xr[64 * j]; s += (v[j].x * v[j].x + v[j].y * v[j].y) + (v[j].z * v[j].z + v[j].w * v[j].w); }
        const float rstd = rsqrtf(wave_sum(s) * (1.f / DM) + EPS);
#pragma unroll
        for (int j = 0; j < 4; ++j) { const f32x4 gg = *((const f32x4*)g_final + lane + 64 * j); xr[64 * j] = v[j] * rstd * gg; }
    } }
}

extern "C" void kernel_launch(void* const* d_in, const int* in_sizes, int n_in, void* d_out, int out_size, void* d_ws, size_t ws_size, hipStream_t stream) {
    static int grid = 0;
    if (grid == 0) {
        if (n_in != 12 || in_sizes[0] != M * DM || out_size != M * DM || ws_size < WS_END) { fprintf(stderr, "kernel_launch: unexpected shapes (n_in %d, in0 %d, out %d, ws %zu)\n", n_in, n_in > 0 ? in_sizes[0] : -1, out_size, ws_size); grid = -1; return; }
        int dev = 0, cus = 0, per_cu = 0;
        if (hipGetDevice(&dev) != hipSuccess || hipDeviceGetAttribute(&cus, hipDeviceAttributeMultiprocessorCount, dev) != hipSuccess) { grid = -1; return; }
        if (hipFuncSetAttribute((const void*)mk_fwd, hipFuncAttributeMaxDynamicSharedMemorySize, LDS_BYTES) != hipSuccess) { fprintf(stderr, "kernel_launch: hipFuncSetAttribute failed\n"); grid = -1; return; }
        if (hipOccupancyMaxActiveBlocksPerMultiprocessor(&per_cu, (const void*)mk_fwd, NWAVES * 64, LDS_BYTES) != hipSuccess || per_cu < 1)
            fprintf(stderr, "kernel_launch: note: occupancy query reports %d workgroups per CU\n", per_cu);
        (void)hipGetLastError();
        grid = cus;
    }
    if (grid < 0) return;
    if (hipMemsetAsync((char*)d_ws + WS_CTL, 0, CTL_ZERO_BYTES, stream) != hipSuccess) { fprintf(stderr, "kernel_launch: memset failed\n"); return; }
    Args a{};
    for (int i = 0; i < 12; ++i) a.in[i] = (const float*)d_in[i];
    a.out = (float*)d_out; a.ws = (unsigned char*)d_ws;
    hipLaunchKernelGGL(mk_fwd, dim3(grid), dim3(NWAVES * 64), LDS_BYTES, stream, a);
    const hipError_t le = hipPeekAtLastError();
    if (le != hipSuccess) fprintf(stderr, "kernel_launch: launch failed: %s\n", hipGetErrorName(le));
}
```
